# Optimizing an MI355X kernel written in HIP

```python
import jax, jax.numpy as jnp
from jax import lax
import numpy as np

D_MODEL = 1024
BATCH = 4
SEQ = 4096
DEPTH = 1

NSA_HEADS = 8
NSA_KV_GROUPS = 2
NSA_HPG = NSA_HEADS // NSA_KV_GROUPS
NSA_HEAD_DIM = 64
NSA_WIDTH = NSA_HEADS * NSA_HEAD_DIM
NSA_KV_WIDTH = NSA_KV_GROUPS * NSA_HEAD_DIM
CMP_BLOCK = 32
CMP_STRIDE = 16
CMP_HIDDEN = 128
SLC_BLOCK = 64
SLC_TOPK = 16
WINDOW = 512
N_BRANCH = 3
FORCED_SCORE = 1.0e4
MLA_HEADS = 8
MLA_NOPE_DIM = 64
MLA_ROPE_DIM = 32
MLA_V_DIM = 64
MLA_WIDTH = MLA_HEADS * MLA_V_DIM
MLA_Q_RANK = 256
MLA_KV_RANK = 128
MIX_WIDTH = NSA_WIDTH + MLA_WIDTH
Q_BLOCK = 128
ROPE_THETA = 10000.0
NORM_EPS = 1e-6
NEG_INF = -1e30

IN_SIZES = (
    NSA_WIDTH,
    NSA_KV_WIDTH, NSA_KV_WIDTH,
    NSA_KV_WIDTH, NSA_KV_WIDTH,
    NSA_KV_WIDTH, NSA_KV_WIDTH,
    NSA_HEADS * N_BRANCH,
    NSA_WIDTH,
    MLA_Q_RANK,
    MLA_KV_RANK,
    MLA_ROPE_DIM,
    MLA_WIDTH,
)
IN_WIDTH = sum(IN_SIZES)
IN_OFFSETS = tuple(int(o) for o in np.cumsum(IN_SIZES)[:-1])

kernel_name = "hymba_nsa_mla_adaln_block"


def rms_norm(x, g):
    xf = x.astype(jnp.float32)
    y = xf * lax.rsqrt(jnp.mean(xf * xf, axis=-1, keepdims=True) + NORM_EPS)
    return (y * g.astype(jnp.float32)).astype(x.dtype)


def rope(x, pos):
    half = x.shape[-1] // 2
    inv = ROPE_THETA ** (-jnp.arange(half, dtype=jnp.float32) / half)
    ang = pos.astype(jnp.float32)[..., None] * inv
    cos = jnp.cos(ang)[:, :, None, :]
    sin = jnp.sin(ang)[:, :, None, :]
    xf = x.astype(jnp.float32)
    x1, x2 = xf[..., :half], xf[..., half:]
    out = jnp.concatenate([x1 * cos - x2 * sin, x2 * cos + x1 * sin], axis=-1)
    return out.astype(x.dtype)


def masked_softmax(s, mask):
    s = jnp.where(mask, s.astype(jnp.float32), NEG_INF)
    p = jax.nn.softmax(s, axis=-1)
    return jnp.where(mask, p, 0.0)


def compress(kv, cmp_pos, w1, w2):
    B, S, G, D = kv.shape
    r = CMP_BLOCK // CMP_STRIDE
    ns = S // CMP_STRIDE
    sub = kv.reshape(B, ns, CMP_STRIDE, G, D)
    nc = ns - r + 1
    blocks = jnp.concatenate([sub[:, j:j + nc] for j in range(r)], axis=2)
    blocks = blocks + cmp_pos[None, None, :, None, :]
    flat = blocks.transpose(0, 1, 3, 2, 4).reshape(B, nc, G, CMP_BLOCK * D)
    return jax.nn.silu(flat @ w1) @ w2


def cmp_to_slc_matrix(nc, nslc):
    start = np.arange(nc)[:, None] * CMP_STRIDE
    bstart = np.arange(nslc)[None, :] * SLC_BLOCK
    ov = np.minimum(start + CMP_BLOCK, bstart + SLC_BLOCK) - np.maximum(start, bstart)
    return (np.clip(ov, 0, None) / CMP_BLOCK).astype(np.float32)


def nsa_attention(q, k_cmp, v_cmp, k_slc, v_slc, k_win, v_win, gate_logits, positions,
                  cmp_pos, cmp_k_w1, cmp_k_w2, cmp_v_w1, cmp_v_w2):
    B, S = q.shape[:2]
    G, HPG, dk = NSA_KV_GROUPS, NSA_HPG, NSA_HEAD_DIM
    scale = dk ** -0.5
    nqb = S // Q_BLOCK
    t = np.arange(S)
    qg = rope(q.reshape(B, S, NSA_HEADS, dk), positions).reshape(B, S, G, HPG, dk)

    kc = compress(k_cmp.reshape(B, S, G, dk), cmp_pos, cmp_k_w1, cmp_k_w2)
    vc = compress(v_cmp.reshape(B, S, G, dk), cmp_pos, cmp_v_w1, cmp_v_w2)
    nc = kc.shape[1]
    cmp_end = np.arange(nc) * CMP_STRIDE + CMP_BLOCK - 1
    kc = rope(kc, positions[:, cmp_end])
    s_cmp = jnp.einsum('bsghd,bngd->bghsn', qg, kc).astype(jnp.float32) * scale
    p_cmp = masked_softmax(s_cmp, cmp_end[None, :] <= t[:, None])
    o_cmp = jnp.einsum('bghsn,bngd->bsghd', p_cmp.astype(vc.dtype), vc)

    nslc = S // SLC_BLOCK
    m = jnp.asarray(cmp_to_slc_matrix(nc, nslc))
    imp = jnp.einsum('bghsn,nj->bgsj', p_cmp, m)
    blk = np.arange(nslc)[None, :]
    cur = (t // SLC_BLOCK)[:, None]
    forced = (blk == 0) | (blk == cur) | (blk == cur - 1)
    imp = jnp.where(forced, FORCED_SCORE, jnp.where(blk > cur, -FORCED_SCORE, imp))
    n_sel = min(SLC_TOPK, nslc)
    _, sel_idx = lax.top_k(imp, n_sel)

    kb = rope(k_slc.reshape(B, S, G, dk), positions).reshape(B, nslc, SLC_BLOCK, G, dk).transpose(0, 3, 1, 2, 4)
    vb = v_slc.reshape(B, nslc, SLC_BLOCK, G, dk).transpose(0, 3, 1, 2, 4)
    q_chunks = qg.reshape(B, nqb, Q_BLOCK, G, HPG, dk).transpose(1, 0, 3, 2, 4, 5)
    idx_chunks = sel_idx.reshape(B, G, nqb, Q_BLOCK, n_sel).transpose(2, 0, 1, 3, 4)
    t_chunks = jnp.arange(S, dtype=jnp.int32).reshape(nqb, Q_BLOCK)
    gather = jax.vmap(jax.vmap(lambda blocks, ix: blocks[ix]))
    sb_offsets = jnp.arange(SLC_BLOCK, dtype=jnp.int32)

    def slc_block(args):
        qc, ic, tc = args
        kg = gather(kb, ic)
        vg = gather(vb, ic)
        s = jnp.einsum('bgqhd,bgqnkd->bgqhnk', qc, kg).astype(jnp.float32) * scale
        key_pos = ic[..., None] * SLC_BLOCK + sb_offsets
        mask = (key_pos <= tc[None, None, :, None, None]).reshape(B, G, Q_BLOCK, 1, n_sel * SLC_BLOCK)
        p = masked_softmax(s.reshape(B, G, Q_BLOCK, HPG, n_sel * SLC_BLOCK), mask)
        p = p.reshape(B, G, Q_BLOCK, HPG, n_sel, SLC_BLOCK)
        return jnp.einsum('bgqhnk,bgqnkd->bqghd', p.astype(vg.dtype), vg)

    o_slc = lax.map(slc_block, (q_chunks, idx_chunks, t_chunks))
    o_slc = o_slc.transpose(1, 0, 2, 3, 4, 5).reshape(B, S, G, HPG, dk)

    n_back = WINDOW // Q_BLOCK

    def band(a):
        ap = jnp.pad(a, ((0, 0), (WINDOW, 0), (0, 0), (0, 0)))
        ab = ap.reshape(B, nqb + n_back, Q_BLOCK, G, dk)
        return jnp.concatenate([ab[:, j:j + nqb] for j in range(n_back + 1)], axis=2)

    kband = band(rope(k_win.reshape(B, S, G, dk), positions))
    vband = band(v_win.reshape(B, S, G, dk))
    qw = qg.reshape(B, nqb, Q_BLOCK, G, HPG, dk)
    s_win = jnp.einsum('bnqghd,bnkgd->bnghqk', qw, kband).astype(jnp.float32) * scale
    q_idx = np.arange(nqb)[:, None] * Q_BLOCK + np.arange(Q_BLOCK)[None, :]
    k_idx = np.arange(nqb)[:, None] * Q_BLOCK - WINDOW + np.arange((n_back + 1) * Q_BLOCK)[None, :]
    diff = q_idx[:, :, None] - k_idx[:, None, :]
    win_mask = (diff >= 0) & (diff < WINDOW) & (k_idx[:, None, :] >= 0)
    p_win = masked_softmax(s_win, win_mask[None, :, None, None])
    o_win = jnp.einsum('bnghqk,bnkgd->bnqghd', p_win.astype(vband.dtype), vband).reshape(B, S, G, HPG, dk)

    g = jax.nn.sigmoid(gate_logits.astype(jnp.float32)).reshape(B, S, G, HPG, N_BRANCH).astype(q.dtype)
    o = g[..., 0:1] * o_cmp + g[..., 1:2] * o_slc + g[..., 2:3] * o_win
    return o.reshape(B, S, NSA_WIDTH)


def mla_attention(c_q, c_kv, k_rope, positions, q_norm_g, w_q_up, kv_norm_g, w_kv_up):
    B, S = c_q.shape[:2]
    H = MLA_HEADS
    nqb = S // Q_BLOCK
    q = (rms_norm(c_q, q_norm_g) @ w_q_up).reshape(B, S, H, MLA_NOPE_DIM + MLA_ROPE_DIM)
    q_nope = q[..., :MLA_NOPE_DIM]
    q_rot = rope(q[..., MLA_NOPE_DIM:], positions)
    kv = (rms_norm(c_kv, kv_norm_g) @ w_kv_up).reshape(B, S, H, MLA_NOPE_DIM + MLA_V_DIM)
    k_nope, v = kv[..., :MLA_NOPE_DIM], kv[..., MLA_NOPE_DIM:]
    k_rot = rope(k_rope[:, :, None, :], positions)[:, :, 0]
    scale = (MLA_NOPE_DIM + MLA_ROPE_DIM) ** -0.5
    qn_c = q_nope.reshape(B, nqb, Q_BLOCK, H, MLA_NOPE_DIM).transpose(1, 0, 2, 3, 4)
    qr_c = q_rot.reshape(B, nqb, Q_BLOCK, H, MLA_ROPE_DIM).transpose(1, 0, 2, 3, 4)
    t_chunks = jnp.arange(S, dtype=jnp.int32).reshape(nqb, Q_BLOCK)
    key_idx = jnp.arange(S, dtype=jnp.int32)

    def mla_block(args):
        qn, qr, tc = args
        s = (jnp.einsum('bqhd,bkhd->bhqk', qn, k_nope)
             + jnp.einsum('bqhd,bkd->bhqk', qr, k_rot)).astype(jnp.float32) * scale
        p = masked_softmax(s, key_idx[None, :] <= tc[:, None])
        return jnp.einsum('bhqk,bkhd->bqhd', p.astype(v.dtype), v)

    o = lax.map(mla_block, (qn_c, qr_c, t_chunks))
    return o.transpose(1, 0, 2, 3, 4).reshape(B, S, MLA_WIDTH)


def setup_inputs(seed: int = 0) -> dict:
    key = jax.random.key(seed)
    ks = jax.random.split(key, 20)
    f32 = jnp.float32
    L, D = DEPTH, D_MODEL

    def nrm(k, shape, fan_in, gain=1.0):
        return jax.random.normal(k, shape, f32) * (gain * fan_in ** -0.5)

    def gain(k, shape):
        return 1.0 + 0.02 * jax.random.normal(k, shape, f32)

    x = jax.random.normal(ks[0], (BATCH, SEQ, D), f32)
    c = jax.random.normal(ks[1], (BATCH, D), f32)
    offset = jax.random.randint(ks[2], (BATCH, 1), 0, 1024, dtype=jnp.int32)
    positions = offset + jnp.arange(SEQ, dtype=jnp.int32)[None, :]
    return {
        "x": x,
        "c": c,
        "positions": positions,
        "ada_w": nrm(ks[3], (L, D, 3 * D), D, 0.5),
        "ada_b": 0.01 * jax.random.normal(ks[4], (L, 3 * D), f32),
        "norm_g": gain(ks[5], (L, D)),
        "w_in": nrm(ks[6], (L, D, IN_WIDTH), D),
        "cmp_pos": 0.02 * jax.random.normal(ks[7], (L, CMP_BLOCK, NSA_HEAD_DIM), f32),
        "cmp_k_w1": nrm(ks[8], (L, CMP_BLOCK * NSA_HEAD_DIM, CMP_HIDDEN), CMP_BLOCK * NSA_HEAD_DIM),
        "cmp_k_w2": nrm(ks[9], (L, CMP_HIDDEN, NSA_HEAD_DIM), CMP_HIDDEN),
        "cmp_v_w1": nrm(ks[10], (L, CMP_BLOCK * NSA_HEAD_DIM, CMP_HIDDEN), CMP_BLOCK * NSA_HEAD_DIM),
        "cmp_v_w2": nrm(ks[11], (L, CMP_HIDDEN, NSA_HEAD_DIM), CMP_HIDDEN),
        "q_norm_g": gain(ks[12], (L, MLA_Q_RANK)),
        "w_q_up": nrm(ks[13], (L, MLA_Q_RANK, MLA_HEADS * (MLA_NOPE_DIM + MLA_ROPE_DIM)), MLA_Q_RANK),
        "kv_norm_g": gain(ks[14], (L, MLA_KV_RANK)),
        "w_kv_up": nrm(ks[15], (L, MLA_KV_RANK, MLA_HEADS * (MLA_NOPE_DIM + MLA_V_DIM)), MLA_KV_RANK),
        "w_out": nrm(ks[16], (L, MIX_WIDTH, D), MIX_WIDTH),
        "final_norm_g": gain(ks[17], (D,)),
    }


def reference(x, c, positions, ada_w, ada_b, norm_g, w_in, cmp_pos, cmp_k_w1, cmp_k_w2,
              cmp_v_w1, cmp_v_w2, q_norm_g, w_q_up, kv_norm_g, w_kv_up, w_out, final_norm_g):
    for l in range(DEPTH):
        mod = jax.nn.silu(c) @ ada_w[l] + ada_b[l]
        shift, scl, gate = jnp.split(mod, 3, axis=-1)
        h = rms_norm(x, norm_g[l]) * (1.0 + scl[:, None, :]) + shift[:, None, :]

        proj = h @ w_in[l]
        (q_n, kc_n, vc_n, ks_n, vs_n, kw_n, vw_n, gl_n, z_nsa,
         cq_m, ckv_m, kr_m, z_mla) = jnp.split(proj, IN_OFFSETS, axis=-1)

        o_nsa = nsa_attention(q_n, kc_n, vc_n, ks_n, vs_n, kw_n, vw_n, gl_n, positions,
                              cmp_pos[l], cmp_k_w1[l], cmp_k_w2[l], cmp_v_w1[l], cmp_v_w2[l])
        o_mla = mla_attention(cq_m, ckv_m, kr_m, positions,
                              q_norm_g[l], w_q_up[l], kv_norm_g[l], w_kv_up[l])

        mixed = jnp.concatenate([o_nsa * jax.nn.silu(z_nsa), o_mla * jax.nn.silu(z_mla)], axis=-1)
        x = x + gate[:, None, :] * (mixed @ w_out[l])
    return rms_norm(x, final_norm_g)
```

```cpp
#include <hip/hip_runtime.h>
#include <hip/hip_cooperative_groups.h>
#include <cmath>
#include <cstdio>
namespace cg = cooperative_groups;

typedef unsigned short bf16_t;
typedef __attribute__((ext_vector_type(8))) short bf16x8;
typedef __attribute__((ext_vector_type(4))) float f32x4;
typedef unsigned long long u64;

#define DI __device__ __forceinline__
#define MFMA16(a, b, c) __builtin_amdgcn_mfma_f32_16x16x32_bf16((a), (b), (c), 0, 0, 0)

constexpr int T_TOK = 16384, S_LEN = 4096;
constexpr int LDP = 2752;
constexpr int NPADW = 2816;
constexpr int PC_KC = 512, PC_VC = 640, PC_KS = 768, PC_KW = 1024, PC_ZN = 1280, PC_CQ = 1792,
              PC_CKV = 2048, PC_ZM = 2176, PC_KR = 2688, PC_GL = 2720;
constexpr float NEGF = -1e30f;
constexpr int SMEM_BYTES = 65536;
constexpr int LDK = 104;
constexpr int LDV = 72;

struct Params {
  const float* x; const float* c; const int* pos; const float* ada_w; const float* ada_b; const float* norm_g;
  const float* w_in; const float* cmp_pos; const float* cmp_k_w1; const float* cmp_k_w2; const float* cmp_v_w1;
  const float* cmp_v_w2; const float* q_norm_g; const float* w_q_up; const float* kv_norm_g; const float* w_kv_up;
  const float* w_out; const float* final_g;
  float* out;
  bf16_t *WinT, *WoutT, *WqT, *WkvT, *W1kT, *W1vT, *W2kT, *W2vT;
  float *modp, *gatef, *cbp, *cpart; float2 *cs64, *cs32;
  unsigned* bar; bf16_t *H, *P, *VsT, *VwT; float* ssq; bf16_t *Qm, *Kn, *VmT, *KC, *VCt, *MIX;
  double inv64[32]; double inv32[16];
  unsigned char order[256];
};

DI float bf2f(bf16_t v) { return __uint_as_float(((unsigned)v) << 16); }
typedef __bf16 bf16x2_t __attribute__((ext_vector_type(2)));
typedef float f32x2_t __attribute__((ext_vector_type(2)));
DI unsigned pack2(float a, float b) { const f32x2_t v = {a, b}; return __builtin_bit_cast(unsigned, __builtin_convertvector(v, bf16x2_t)); }
DI bf16_t f2bf(float a) { return (bf16_t)(pack2(a, a) & 0xffffu); }
DI float wave_sum(float v) {
  v += __shfl_xor(v, 32); v += __shfl_xor(v, 16); v += __shfl_xor(v, 8);
  v += __shfl_xor(v, 4); v += __shfl_xor(v, 2); v += __shfl_xor(v, 1); return v;
}
DI void zero_acc44(f32x4 (&a)[4][4]) {
#pragma unroll
  for (int i = 0; i < 4; ++i)
#pragma unroll
    for (int j = 0; j < 4; ++j) a[i][j] = f32x4{0.f, 0.f, 0.f, 0.f};
}
DI void zero_acc42(f32x4 (&a)[4][2]) {
#pragma unroll
  for (int i = 0; i < 4; ++i)
#pragma unroll
    for (int j = 0; j < 2; ++j) a[i][j] = f32x4{0.f, 0.f, 0.f, 0.f};
}

template <class FA, class FB>
DI void gemm128(f32x4 (&acc)[4][4], int K, FA loadA, FB loadB, bf16_t* sbase) {
  int tid = threadIdx.x; asm volatile("" : "+v"(tid)); const int lane = tid & 63, wave = tid >> 6;
  const int wm = wave >> 1, wn = wave & 1;
  const int lr = tid >> 3, lc = (tid & 7) * 8;
  const int c = lane & 15, g = lane >> 4;
  const int wsw = (((tid & 7) ^ ((lr >> 1) & 7)) << 3);
  const int rsw = (c >> 1) & 7;
  const int nk = K >> 6;
  uint4 ra[4], rb[4];
#pragma unroll
  for (int p = 0; p < 4; ++p) { ra[p] = loadA(lr + 32 * p, lc); rb[p] = loadB(lr + 32 * p, lc); }
  __syncthreads();
#pragma unroll
  for (int p = 0; p < 4; ++p) {
    *(uint4*)(sbase + (lr + 32 * p) * 64 + wsw) = ra[p];
    *(uint4*)(sbase + 8192 + (lr + 32 * p) * 64 + wsw) = rb[p];
  }
  if (nk > 1) {
#pragma unroll
    for (int p = 0; p < 4; ++p) { ra[p] = loadA(lr + 32 * p, 64 + lc); rb[p] = loadB(lr + 32 * p, 64 + lc); }
  }
  for (int it = 0; it < nk; ++it) {
    bf16_t* sA = sbase + (it & 1) * 16384;
    bf16_t* sB = sA + 8192;
    bf16_t* nA = sbase + ((it & 1) ^ 1) * 16384;
    __syncthreads();
    if (it + 1 < nk) {
#pragma unroll
      for (int p = 0; p < 4; ++p) {
        *(uint4*)(nA + (lr + 32 * p) * 64 + wsw) = ra[p];
        *(uint4*)(nA + 8192 + (lr + 32 * p) * 64 + wsw) = rb[p];
      }
      if (it + 2 < nk) {
        const int k2 = (it + 2) * 64 + lc;
#pragma unroll
        for (int p = 0; p < 4; ++p) { ra[p] = loadA(lr + 32 * p, k2); rb[p] = loadB(lr + 32 * p, k2); }
      }
    }
#pragma unroll
    for (int ks = 0; ks < 2; ++ks) {
      bf16x8 af[4], bfr[4];
#pragma unroll
      for (int mi = 0; mi < 4; ++mi) af[mi] = *(const bf16x8*)(sA + (wm * 64 + mi * 16 + c) * 64 + (((ks * 4 + g) ^ rsw) << 3));
#pragma unroll
      for (int ni = 0; ni < 4; ++ni) bfr[ni] = *(const bf16x8*)(sB + (wn * 64 + ni * 16 + c) * 64 + (((ks * 4 + g) ^ rsw) << 3));
#pragma unroll
      for (int mi = 0; mi < 4; ++mi)
#pragma unroll
        for (int ni = 0; ni < 4; ++ni) acc[mi][ni] = MFMA16(af[mi], bfr[ni], acc[mi][ni]);
    }
  }
}

template <class FA, class FB>
DI void gemm256(f32x4 (&accA)[4][4], f32x4 (&accB)[4][4], int K, FA loadA, FB loadB, bf16_t* sbase) {
  int tid = threadIdx.x; asm volatile("" : "+v"(tid)); const int lane = tid & 63, wave = tid >> 6;
  const int wm = wave >> 1, wn = wave & 1;
  const int lr = tid >> 3, lc = (tid & 7) * 8;
  const int c = lane & 15, g = lane >> 4;
  const int wsw = (((tid & 7) ^ ((lr >> 1) & 7)) << 3);
  const int rsw = (c >> 1) & 7;
  bf16_t* sA = sbase; bf16_t* sB = sbase + 256 * 64;
  uint4 ra[8], rb[4];
#pragma unroll
  for (int p = 0; p < 8; ++p) ra[p] = loadA(lr + 32 * p, lc);
#pragma unroll
  for (int p = 0; p < 4; ++p) rb[p] = loadB(lr + 32 * p, lc);
  for (int k0 = 0; k0 < K; k0 += 64) {
    __syncthreads();
#pragma unroll
    for (int p = 0; p < 8; ++p) *(uint4*)(sA + (lr + 32 * p) * 64 + wsw) = ra[p];
#pragma unroll
    for (int p = 0; p < 4; ++p) *(uint4*)(sB + (lr + 32 * p) * 64 + wsw) = rb[p];
    __syncthreads();
    if (k0 + 64 < K) {
#pragma unroll
      for (int p = 0; p < 8; ++p) ra[p] = loadA(lr + 32 * p, k0 + 64 + lc);
#pragma unroll
      for (int p = 0; p < 4; ++p) rb[p] = loadB(lr + 32 * p, k0 + 64 + lc);
    }
#pragma unroll
    for (int ks = 0; ks < 2; ++ks) {
      const int ko = (((ks * 4 + g) ^ rsw) << 3);
      bf16x8 bfr[4], af0[4], af1[4];
#pragma unroll
      for (int ni = 0; ni < 4; ++ni) bfr[ni] = *(const bf16x8*)(sB + (wn * 64 + ni * 16 + c) * 64 + ko);
#pragma unroll
      for (int mi = 0; mi < 4; ++mi) af0[mi] = *(const bf16x8*)(sA + (wm * 128 + mi * 16 + c) * 64 + ko);
#pragma unroll
      for (int mi = 0; mi < 4; ++mi) af1[mi] = *(const bf16x8*)(sA + (wm * 128 + 64 + mi * 16 + c) * 64 + ko);
      __builtin_amdgcn_sched_barrier(0);
#pragma unroll
      for (int mi = 0; mi < 4; ++mi)
#pragma unroll
        for (int ni = 0; ni < 4; ++ni) accA[mi][ni] = MFMA16(af0[mi], bfr[ni], accA[mi][ni]);
#pragma unroll
      for (int mi = 0; mi < 4; ++mi)
#pragma unroll
        for (int ni = 0; ni < 4; ++ni) accB[mi][ni] = MFMA16(af1[mi], bfr[ni], accB[mi][ni]);
      __builtin_amdgcn_sched_barrier(0);
    }
  }
}

DI int mapcol(int mode, int p) {
  if (mode == 0) return p;
  if (mode == 1) {
    if (p < 1280) return p;
    if (p < 1792) return 1304 + (p - 1280);
    if (p < 2048) return 1816 + (p - 1792);
    if (p < 2176) return 2072 + (p - 2048);
    if (p < 2688) return 2232 + (p - 2176);
    if (p < 2720) return 2200 + (p - 2688);
    if (p < 2744) return 1280 + (p - 2720);
    return -1;
  }
  if (mode == 2) {
    if (p < 512) return (p >> 6) * 96 + (p & 63);
    int q = p - 512; return (q >> 5) * 96 + 64 + (q & 31);
  }
  if (p < 512) return (p >> 6) * 128 + (p & 63);
  int q = p - 512; return (q >> 6) * 128 + 64 + (q & 63);
}

DI void tr_tile(const float* __restrict__ src, int Nsrc, int K, bf16_t* __restrict__ dst, int k0, int n0, int mode,
                const float* __restrict__ scale, float* tile) {
  int tid = threadIdx.x; asm volatile("" : "+v"(tid)); const int tx = tid & 63, ty = tid >> 6;
  const int sc = mapcol(mode, n0 + tx);
  float v[16];
#pragma unroll
  for (int i = 0; i < 16; ++i) {
    const int kk = ty + 4 * i;
    v[i] = 0.f;
    if (sc >= 0) { v[i] = src[(size_t)(k0 + kk) * Nsrc + sc]; if (scale) v[i] *= scale[k0 + kk]; }
  }
  __syncthreads();
#pragma unroll
  for (int i = 0; i < 16; ++i) tile[(ty + 4 * i) * 65 + tx] = v[i];
  __syncthreads();
#pragma unroll
  for (int i = 0; i < 16; ++i) { const int nn = ty + 4 * i; dst[(size_t)(n0 + nn) * K + k0 + tx] = f2bf(tile[tx * 65 + nn]); }
}

template <bool MOD>
__device__ void prep_items(const Params& p, char* smem) {
  float* tile = (float*)smem;
  int tid = threadIdx.x; asm volatile("" : "+v"(tid));
  constexpr int N_MOD = 192, N_TR = 1172, N_CB = 16;
  for (int it = MOD ? blockIdx.x : N_MOD + blockIdx.x; it < (MOD ? N_MOD : N_MOD + N_TR + N_CB); it += gridDim.x) {
    if (it >= N_MOD && it < N_MOD + N_CB) {
      const int t = it - N_MOD, which = t >> 3, kc = t & 7;
      const float* w1 = which ? p.cmp_v_w1 : p.cmp_k_w1;
      const int hid = tid & 127, hf = tid >> 7;
      float a0 = 0.f, a1 = 0.f, a2 = 0.f, a3 = 0.f;
      const int kb0 = kc * 256 + hf * 128;
#pragma unroll 4
      for (int k = 0; k < 128; k += 4) {
        a0 += p.cmp_pos[kb0 + k] * w1[(size_t)(kb0 + k) * 128 + hid];
        a1 += p.cmp_pos[kb0 + k + 1] * w1[(size_t)(kb0 + k + 1) * 128 + hid];
        a2 += p.cmp_pos[kb0 + k + 2] * w1[(size_t)(kb0 + k + 2) * 128 + hid];
        a3 += p.cmp_pos[kb0 + k + 3] * w1[(size_t)(kb0 + k + 3) * 128 + hid];
      }
      const float a = (a0 + a1) + (a2 + a3);
      __syncthreads();
      tile[tid] = a;
      __syncthreads();
      if (tid < 128) p.cbp[(which * 8 + kc) * 128 + tid] = tile[tid] + tile[tid + 128];
    } else if (it < N_MOD) {
      const int nt = it % 12, kc = it / 12;
      __syncthreads();
      { const int b = tid >> 6, k = tid & 63; const float v = p.c[b * 1024 + kc * 64 + k]; tile[tid] = v / (1.f + expf(-v)); }
      __syncthreads();
      const int n = nt * 256 + tid;
      float a0 = 0.f, a1 = 0.f, a2 = 0.f, a3 = 0.f;
#pragma unroll 16
      for (int k = 0; k < 64; ++k) {
        const float w = p.ada_w[(size_t)(kc * 64 + k) * 3072 + n];
        a0 += tile[k] * w; a1 += tile[64 + k] * w; a2 += tile[128 + k] * w; a3 += tile[192 + k] * w;
      }
      p.modp[(kc * 4 + 0) * 3072 + n] = a0; p.modp[(kc * 4 + 1) * 3072 + n] = a1;
      p.modp[(kc * 4 + 2) * 3072 + n] = a2; p.modp[(kc * 4 + 3) * 3072 + n] = a3;
    } else {
      int t = it - N_MOD - N_CB;
      if (t < 704) { tr_tile(p.w_in, 2744, 1024, p.WinT, (t / 44) * 64, (t % 44) * 64, 1, nullptr, tile); continue; }
      t -= 704;
      if (t < 256) { tr_tile(p.w_out, 1024, 1024, p.WoutT, (t / 16) * 64, (t % 16) * 64, 0, nullptr, tile); continue; }
      t -= 256;
      if (t < 48) { tr_tile(p.w_q_up, 768, 256, p.WqT, (t / 12) * 64, (t % 12) * 64, 2, p.q_norm_g, tile); continue; }
      t -= 48;
      if (t < 32) { tr_tile(p.w_kv_up, 1024, 128, p.WkvT, (t / 16) * 64, (t % 16) * 64, 3, p.kv_norm_g, tile); continue; }
      t -= 32;
      if (t < 64) { tr_tile(p.cmp_k_w1, 128, 2048, p.W1kT, (t / 2) * 64, (t % 2) * 64, 0, nullptr, tile); continue; }
      t -= 64;
      if (t < 64) { tr_tile(p.cmp_v_w1, 128, 2048, p.W1vT, (t / 2) * 64, (t % 2) * 64, 0, nullptr, tile); continue; }
      t -= 64;
      if (t < 2) { tr_tile(p.cmp_k_w2, 64, 128, p.W2kT, t * 64, 0, 0, nullptr, tile); continue; }
      t -= 2;
      tr_tile(p.cmp_v_w2, 64, 128, p.W2vT, t * 64, 0, 0, nullptr, tile);
    }
  }
  if (MOD) return;
  double* sinv = (double*)smem;
  __syncthreads();
  if (tid < 32) sinv[tid] = p.inv64[tid]; else if (tid < 48) sinv[tid] = p.inv32[tid - 32];
  __syncthreads();
  for (int idx = blockIdx.x * 256 + tid; idx < T_TOK * 48; idx += gridDim.x * 256) {
    const int tok = idx / 48, e = idx % 48;
    const double inv = sinv[e];
    double rev = (double)p.pos[tok] * inv * 0.15915494309189535;
    rev -= floor(rev);
    const float ang = (float)(rev * 6.283185307179586);
    const float2 cs = make_float2(__cosf(ang), __sinf(ang));
    if (e < 32) p.cs64[tok * 32 + e] = cs; else p.cs32[tok * 16 + (e - 32)] = cs;
  }
}

__device__ void phase1a(const Params& p, char* smem) {
  float* sa = (float*)smem; float* ssh = sa + 1024;
  int tid = threadIdx.x; asm volatile("" : "+v"(tid)); const int lane = tid & 63, wave = tid >> 6;
  for (int idx = blockIdx.x * 256 + tid; idx < 4096; idx += gridDim.x * 256) {
    const int b = idx >> 10, n = idx & 1023;
    float v = p.ada_b[2048 + n];
    for (int kc = 0; kc < 16; ++kc) v += p.modp[(kc * 4 + b) * 3072 + 2048 + n];
    p.gatef[idx] = v;
  }
  for (int ch = blockIdx.x; ch < 512; ch += gridDim.x) {
    const int b = (ch * 32) / S_LEN;
    __syncthreads();
    for (int n = tid; n < 1024; n += 256) {
      float sh = p.ada_b[n], sc = p.ada_b[1024 + n];
      for (int kc = 0; kc < 16; ++kc) { sh += p.modp[(kc * 4 + b) * 3072 + n]; sc += p.modp[(kc * 4 + b) * 3072 + 1024 + n]; }
      sa[n] = p.norm_g[n] * (1.f + sc); ssh[n] = sh;
    }
    __syncthreads();
    for (int rr = 0; rr < 8; ++rr) {
      const int row = ch * 32 + wave * 8 + rr;
      const float4* xr = (const float4*)(p.x + (size_t)row * 1024);
      float4 v[4]; float ss = 0.f;
#pragma unroll
      for (int i = 0; i < 4; ++i) { v[i] = xr[i * 64 + lane]; ss += v[i].x * v[i].x + v[i].y * v[i].y + v[i].z * v[i].z + v[i].w * v[i].w; }
      ss = wave_sum(ss);
      const float rstd = rsqrtf(ss * (1.f / 1024.f) + 1e-6f);
#pragma unroll
      for (int i = 0; i < 4; ++i) {
        const int col = (i * 64 + lane) * 4;
        const float h0 = v[i].x * rstd * sa[col] + ssh[col], h1 = v[i].y * rstd * sa[col + 1] + ssh[col + 1];
        const float h2 = v[i].z * rstd * sa[col + 2] + ssh[col + 2], h3 = v[i].w * rstd * sa[col + 3] + ssh[col + 3];
        uint2 o; o.x = pack2(h0, h1); o.y = pack2(h2, h3);
        *(uint2*)(p.H + (size_t)row * 1024 + col) = o;
      }
    }
  }
  prep_items<false>(p, smem);
}

DI void store_staged(bf16_t* __restrict__ dst, int ld, f32x4 (&acc)[4][4], int m0, int cb, int lane, bf16_t* stg) {
  const int c = lane & 15, g = lane >> 4;
#pragma unroll
  for (int mi = 0; mi < 4; ++mi)
#pragma unroll
    for (int ni = 0; ni < 4; ++ni)
#pragma unroll
      for (int r = 0; r < 4; ++r) stg[(mi * 16 + g * 4 + r) * 72 + ni * 16 + c] = f2bf(acc[mi][ni][r]);
  asm volatile("s_waitcnt lgkmcnt(0)" ::: "memory");
  const int rr = lane >> 3, cc = (lane & 7) * 8;
#pragma unroll
  for (int i = 0; i < 8; ++i) {
    const uint4 v = *(const uint4*)(stg + (i * 8 + rr) * 72 + cc);
    *(uint4*)(dst + (size_t)(m0 + i * 8 + rr) * ld + cb + cc) = v;
  }
}
DI void store_plain(bf16_t* __restrict__ dst, int ld, f32x4 (&acc)[4][4], int m0, int cb, int lane) {
  const int c = lane & 15, g = lane >> 4;
  bf16_t* base = dst + (size_t)(m0 + g * 4) * ld + cb + c;
#pragma unroll
  for (int mi = 0; mi < 4; ++mi) {
#pragma unroll
    for (int r = 0; r < 4; ++r) {
      bf16_t* rp = base + (size_t)(mi * 16 + r) * ld;
#pragma unroll
      for (int ni = 0; ni < 4; ++ni) rp[ni * 16] = f2bf(acc[mi][ni][r]);
    }
    __builtin_amdgcn_sched_barrier(0);
  }
}
DI void store_T(bf16_t* __restrict__ dstT, int heads_per_b, int hidx, f32x4 (&acc)[4][4], int m0, int lane) {
  const int c = lane & 15, g = lane >> 4;
#pragma unroll
  for (int mi = 0; mi < 4; ++mi) {
    const int tok0 = m0 + mi * 16 + g * 4;
    const int b = tok0 / S_LEN, s0 = tok0 % S_LEN;
#pragma unroll
    for (int ni = 0; ni < 4; ++ni) {
      uint2 o; o.x = pack2(acc[mi][ni][0], acc[mi][ni][1]); o.y = pack2(acc[mi][ni][2], acc[mi][ni][3]);
      *(uint2*)(dstT + ((size_t)(b * heads_per_b + hidx) * 64 + ni * 16 + c) * S_LEN + s0) = o;
    }
  }
}
DI void rope64_acc(const float2* __restrict__ cs64, f32x4 (&acc)[4][4], int m0, int lane) {
  const int c = lane & 15, g = lane >> 4;
#pragma unroll
  for (int mi = 0; mi < 4; ++mi)
#pragma unroll
    for (int r = 0; r < 4; ++r) {
      const int tok = m0 + mi * 16 + g * 4 + r;
#pragma unroll
      for (int h2 = 0; h2 < 2; ++h2) {
        const float2 cs = cs64[tok * 32 + h2 * 16 + c];
        const float x1 = acc[mi][h2][r], x2 = acc[mi][h2 + 2][r];
        acc[mi][h2][r] = x1 * cs.x - x2 * cs.y;
        acc[mi][h2 + 2][r] = x2 * cs.x + x1 * cs.y;
      }
    }
}
DI void rope32_acc(const float2* __restrict__ cs32, f32x4 (&acc)[4][4], int na, int m0, int lane) {
  const int c = lane & 15, g = lane >> 4;
#pragma unroll
  for (int mi = 0; mi < 4; ++mi)
#pragma unroll
    for (int r = 0; r < 4; ++r) {
      const int tok = m0 + mi * 16 + g * 4 + r;
      const float2 cs = cs32[tok * 16 + c];
      const float x1 = acc[mi][na][r], x2 = acc[mi][na + 1][r];
      acc[mi][na][r] = x1 * cs.x - x2 * cs.y;
      acc[mi][na + 1][r] = x2 * cs.x + x1 * cs.y;
    }
}

DI void p1b_epilogue(const Params& p, f32x4 (&acc)[4][4], int m0, int cb, int lane, bf16_t* stg) {
  const int c = lane & 15, g = lane >> 4;
  if (cb >= LDP) return;
  const bool rope64 = (cb < 512) || (cb >= 768 && cb < 896) || (cb >= 1024 && cb < 1152);
  const bool vt = (cb >= 896 && cb < 1024) || (cb >= 1152 && cb < 1280);
  const bool silu = (cb >= PC_ZN && cb < PC_CQ) || (cb >= PC_ZM && cb < PC_KR);
  const bool ssqf = (cb >= PC_CQ && cb < PC_ZM);
  if (rope64) rope64_acc(p.cs64, acc, m0, lane);
  if (silu) {
#pragma unroll
    for (int mi = 0; mi < 4; ++mi)
#pragma unroll
      for (int ni = 0; ni < 4; ++ni)
#pragma unroll
        for (int r = 0; r < 4; ++r) { const float v = acc[mi][ni][r]; acc[mi][ni][r] = v / (1.f + __expf(-v)); }
  }
  if (cb == PC_KR) {
    rope32_acc(p.cs32, acc, 0, m0, lane);
#pragma unroll
    for (int mi = 0; mi < 4; ++mi)
#pragma unroll
      for (int ni = 2; ni < 4; ++ni)
#pragma unroll
        for (int r = 0; r < 4; ++r) { const float v = acc[mi][ni][r]; acc[mi][ni][r] = 1.f / (1.f + __expf(-v)); }
  }
  if (ssqf) {
    const int slot = (cb - PC_CQ) >> 6;
#pragma unroll
    for (int mi = 0; mi < 4; ++mi)
#pragma unroll
      for (int r = 0; r < 4; ++r) {
        float s = 0.f;
#pragma unroll
        for (int ni = 0; ni < 4; ++ni) s += acc[mi][ni][r] * acc[mi][ni][r];
        s += __shfl_xor(s, 8); s += __shfl_xor(s, 4); s += __shfl_xor(s, 2); s += __shfl_xor(s, 1);
        if (c == 0) p.ssq[(size_t)(m0 + mi * 16 + g * 4 + r) * 8 + slot] = s;
      }
  }
  if (vt) {
    bf16_t* dst = (cb < 1024) ? p.VsT : p.VwT;
    const int gk = (cb >> 6) & 1;
    store_T(dst, 2, gk, acc, m0, lane);
  } else {
    store_staged(p.P, LDP, acc, m0, cb, lane, stg);
  }
}

__device__ void phase1b(const Params& p, char* smem) {
  const int xcd = blockIdx.x & 7, lid = blockIdx.x >> 3, nl = (gridDim.x - xcd + 7) >> 3;
  for (int t = lid; t < 176; t += nl) {
    int tid = threadIdx.x; asm volatile("" : "+v"(tid)); const int lane = tid & 63, wave = tid >> 6, wm = wave >> 1, wn = wave & 1;
    int mt, nt;
    if (t < 128) { mt = xcd * 8 + ((t & 63) >> 3); nt = (t >> 6) * 8 + (t & 7); }
    else { const int rem = t - 128; mt = xcd * 8 + rem / 6; nt = 16 + rem % 6; }
    f32x4 accA[4][4], accB[4][4]; zero_acc44(accA); zero_acc44(accB);
    const bf16_t* A = p.H + (size_t)mt * 256 * 1024;
    const bf16_t* B = p.WinT + (size_t)nt * 128 * 1024;
    gemm256(accA, accB, 1024,
            [&](int r, int k) { return *(const uint4*)(A + (size_t)r * 1024 + k); },
            [&](int r, int k) { return *(const uint4*)(B + (size_t)r * 1024 + k); }, (bf16_t*)smem);
    __syncthreads();
    p1b_epilogue(p, accA, mt * 256 + wm * 128, nt * 128 + wn * 64, lane, (bf16_t*)smem + wave * (64 * 72));
    p1b_epilogue(p, accB, mt * 256 + wm * 128 + 64, nt * 128 + wn * 64, lane, (bf16_t*)smem + wave * (64 * 72));
  }
}

DI void scale_rows(const float* __restrict__ ssq, int slot0, int nslot, float invn, f32x4 (&acc)[4][4], int m0, int lane) {
  const int g = lane >> 4;
#pragma unroll
  for (int mi = 0; mi < 4; ++mi) {
#pragma unroll
    for (int r = 0; r < 4; ++r) {
      const int tok = m0 + mi * 16 + g * 4 + r;
      float s;
      if (nslot == 4) { const float4 v = *(const float4*)(ssq + (size_t)tok * 8 + slot0); s = (v.x + v.y) + (v.z + v.w); }
      else { const float2 v = *(const float2*)(ssq + (size_t)tok * 8 + slot0); s = v.x + v.y; }
      const float rstd = rsqrtf(s * invn + 1e-6f);
#pragma unroll
      for (int ni = 0; ni < 4; ++ni) acc[mi][ni][r] *= rstd;
    }
    __builtin_amdgcn_sched_barrier(0);
  }
}

__device__ void compress_finish_item(const Params& p, int which, int b, int gk, int half, char* smem) {
  int tid = threadIdx.x; asm volatile("" : "+v"(tid)); const int lane = tid & 63, wave = tid >> 6;
  const int c = lane & 15, g = lane >> 4;
  const int n0 = half * 128;
  const int bg = b * 2 + gk;
  const bf16_t* W2 = which ? p.W2vT : p.W2kT;
  bf16_t* hid = (bf16_t*)smem;
  const float* part = p.cpart + (size_t)(((which * 8 + bg) * 2 + half) * 8) * 16384;
  __syncthreads();
#pragma unroll 2
  for (int i = 0; i < 16; ++i) {
    const int e4 = tid + 256 * i, row = e4 >> 5, col = (e4 & 31) * 4;
    float4 a = *(const float4*)(part + row * 128 + col);
#pragma unroll
    for (int kc = 1; kc < 8; ++kc) {
      const float4 t = *(const float4*)(part + (size_t)kc * 16384 + row * 128 + col);
      a.x += t.x; a.y += t.y; a.z += t.z; a.w += t.w;
    }
    float4 bb = make_float4(0.f, 0.f, 0.f, 0.f);
#pragma unroll
    for (int kc = 0; kc < 8; ++kc) {
      const float4 t = *(const float4*)(p.cbp + (which * 8 + kc) * 128 + col);
      bb.x += t.x; bb.y += t.y; bb.z += t.z; bb.w += t.w;
    }
    a.x += bb.x; a.y += bb.y; a.z += bb.z; a.w += bb.w;
    uint2 o;
    o.x = pack2(a.x / (1.f + __expf(-a.x)), a.y / (1.f + __expf(-a.y)));
    o.y = pack2(a.z / (1.f + __expf(-a.z)), a.w / (1.f + __expf(-a.w)));
    *(uint2*)(hid + row * 136 + col) = o;
  }
  __syncthreads();
  f32x4 a2[2][4];
#pragma unroll
  for (int mi = 0; mi < 2; ++mi)
#pragma unroll
    for (int ni = 0; ni < 4; ++ni) a2[mi][ni] = f32x4{0.f, 0.f, 0.f, 0.f};
#pragma unroll
  for (int ks = 0; ks < 4; ++ks) {
    bf16x8 af[2], bfr[4];
#pragma unroll
    for (int mi = 0; mi < 2; ++mi) af[mi] = *(const bf16x8*)(hid + (wave * 32 + mi * 16 + c) * 136 + ks * 32 + g * 8);
#pragma unroll
    for (int ni = 0; ni < 4; ++ni) bfr[ni] = *(const bf16x8*)(W2 + (ni * 16 + c) * 128 + ks * 32 + g * 8);
#pragma unroll
    for (int mi = 0; mi < 2; ++mi)
#pragma unroll
      for (int ni = 0; ni < 4; ++ni) a2[mi][ni] = MFMA16(af[mi], bfr[ni], a2[mi][ni]);
  }
  if (which == 0) {
#pragma unroll
    for (int mi = 0; mi < 2; ++mi)
#pragma unroll
      for (int r = 0; r < 4; ++r) {
        const int n = n0 + wave * 32 + mi * 16 + g * 4 + r;
        const bool ok = n < 255;
        const int tok = b * S_LEN + (ok ? 16 * n + 31 : 0);
#pragma unroll
        for (int h2 = 0; h2 < 2; ++h2) {
          const float2 cs = p.cs64[tok * 32 + h2 * 16 + c];
          const float x1 = a2[mi][h2][r], x2 = a2[mi][h2 + 2][r];
          const float o1 = ok ? x1 * cs.x - x2 * cs.y : 0.f, o2 = ok ? x2 * cs.x + x1 * cs.y : 0.f;
          p.KC[((size_t)bg * 256 + n) * 64 + h2 * 16 + c] = f2bf(o1);
          p.KC[((size_t)bg * 256 + n) * 64 + (h2 + 2) * 16 + c] = f2bf(o2);
        }
      }
  } else {
#pragma unroll
    for (int mi = 0; mi < 2; ++mi) {
      const int nb = n0 + wave * 32 + mi * 16 + g * 4;
#pragma unroll
      for (int ni = 0; ni < 4; ++ni) {
        float v[4];
#pragma unroll
        for (int r = 0; r < 4; ++r) v[r] = (nb + r < 255) ? a2[mi][ni][r] : 0.f;
        uint2 o; o.x = pack2(v[0], v[1]); o.y = pack2(v[2], v[3]);
        *(uint2*)(p.VCt + ((size_t)bg * 64 + ni * 16 + c) * 256 + nb) = o;
      }
    }
  }
}
__device__ void phase2b(const Params& p, char* smem) {
  for (int it = blockIdx.x; it < 32; it += gridDim.x)
    compress_finish_item(p, it & 1, (it >> 1) & 3, (it >> 3) & 1, (it >> 4) & 1, smem);
}

__device__ void phase2(const Params& p, char* smem) {
  constexpr int N_CMP = 256, N_Q = 128 * 6, N_KV = 128 * 8;
  int it = blockIdx.x;
  for (; it < N_CMP; it += gridDim.x) {
    int tid = threadIdx.x; asm volatile("" : "+v"(tid)); const int lane = tid & 63, wave = tid >> 6, wm = wave >> 1, wn = wave & 1;
    {
      const int kc = it & 7, item = it >> 3;
      const int half = item & 1, bg = (item >> 1) & 7, which = item >> 4;
      const int b = bg >> 1, gk = bg & 1;
      const bf16_t* src = p.P + (size_t)b * S_LEN * LDP + (which ? PC_VC : PC_KC) + gk * 64;
      const bf16_t* W1 = (which ? p.W1vT : p.W1kT) + kc * 256;
      const int n0 = half * 128;
      f32x4 acc[4][4]; zero_acc44(acc);
      gemm128(acc, 256,
              [&](int r, int k) {
                const int n = n0 + r, kk = kc * 256 + k;
                uint4 o = make_uint4(0u, 0u, 0u, 0u);
                if (n < 255) o = *(const uint4*)(src + (size_t)(16 * n + (kk >> 6)) * LDP + (kk & 63));
                return o;
              },
              [&](int r, int k) { return *(const uint4*)(W1 + (size_t)r * 2048 + k); }, (bf16_t*)smem);
      float* dst = p.cpart + (size_t)it * 16384;
      const int c = lane & 15, g = lane >> 4;
#pragma unroll
      for (int mi = 0; mi < 4; ++mi)
#pragma unroll
        for (int ni = 0; ni < 4; ++ni)
#pragma unroll
          for (int r = 0; r < 4; ++r)
            dst[(wm * 64 + mi * 16 + g * 4 + r) * 128 + wn * 64 + ni * 16 + c] = acc[mi][ni][r];
    }
  }
  for (; it < N_CMP + N_Q; it += gridDim.x) {
    int tid = threadIdx.x; asm volatile("" : "+v"(tid)); const int lane = tid & 63, wave = tid >> 6, wm = wave >> 1, wn = wave & 1;
    {
      const int t = it - N_CMP, mt = t / 6, nt = t % 6;
      f32x4 acc[4][4]; zero_acc44(acc);
      const bf16_t* A = p.P + (size_t)mt * 128 * LDP + PC_CQ;
      const bf16_t* B = p.WqT + (size_t)nt * 128 * 256;
      gemm128(acc, 256,
              [&](int r, int k) { return *(const uint4*)(A + (size_t)r * LDP + k); },
              [&](int r, int k) { return *(const uint4*)(B + (size_t)r * 256 + k); }, (bf16_t*)smem);
      const int m0 = mt * 128 + wm * 64, cb = nt * 128 + wn * 64;
      __syncthreads();
      scale_rows(p.ssq, 0, 4, 1.f / 256.f, acc, m0, lane);
      if (cb >= 512) { rope32_acc(p.cs32, acc, 0, m0, lane); rope32_acc(p.cs32, acc, 2, m0, lane); }
      store_staged(p.Qm, 768, acc, m0, cb, lane, (bf16_t*)smem + wave * (64 * 72));
    }
  }
  for (; it < N_CMP + N_Q + N_KV; it += gridDim.x) {
    int tid = threadIdx.x; asm volatile("" : "+v"(tid)); const int lane = tid & 63, wave = tid >> 6, wm = wave >> 1, wn = wave & 1;
    {
      const int t = it - N_CMP - N_Q, mt = t / 8, nt = t % 8;
      f32x4 acc[4][4]; zero_acc44(acc);
      const bf16_t* A = p.P + (size_t)mt * 128 * LDP + PC_CKV;
      const bf16_t* B = p.WkvT + (size_t)nt * 128 * 128;
      gemm128(acc, 128,
              [&](int r, int k) { return *(const uint4*)(A + (size_t)r * LDP + k); },
              [&](int r, int k) { return *(const uint4*)(B + (size_t)r * 128 + k); }, (bf16_t*)smem);
      const int m0 = mt * 128 + wm * 64, cb = nt * 128 + wn * 64;
      __syncthreads();
      scale_rows(p.ssq, 4, 2, 1.f / 128.f, acc, m0, lane);
      if (cb < 512) store_staged(p.Kn, 512, acc, m0, cb, lane, (bf16_t*)smem + wave * (64 * 72));
      else store_T(p.VmT, 8, (cb - 512) >> 6, acc, m0, lane);
    }
  }
}

typedef __attribute__((ext_vector_type(16))) float f32x16;
#define MFMA32(a, b, c) __builtin_amdgcn_mfma_f32_32x32x16_bf16((a), (b), (c), 0, 0, 0)
constexpr float MASKV = -1e32f;

DI void zero16x2(f32x16 (&a)[2]) {
#pragma unroll
  for (int i = 0; i < 2; ++i)
#pragma unroll
    for (int j = 0; j < 16; ++j) a[i][j] = 0.f;
}
template <int KS>
DI void score32(const bf16x8 (&qf)[KS], const bf16_t* sK, int ldk, f32x16 (&s)[2], int lane) {
  const int r = lane & 31, h = lane >> 5;
#pragma unroll
  for (int kt = 0; kt < 2; ++kt) {
#pragma unroll
    for (int j = 0; j < 16; ++j) s[kt][j] = 0.f;
#pragma unroll
    for (int ks = 0; ks < KS; ++ks) {
      const bf16x8 kf = *(const bf16x8*)(sK + (kt * 32 + r) * ldk + ks * 16 + 8 * h);
      s[kt] = MFMA32(kf, qf[ks], s[kt]);
    }
  }
}
template <int KS>
DI void score32x(const bf16x8 (&qf)[KS], const bf16_t* sK, int ldk, f32x16 (&s)[2], int lane) {
  const int r = lane & 31, h = lane >> 5;
  bf16x8 kf[2][KS];
#pragma unroll
  for (int kt = 0; kt < 2; ++kt)
#pragma unroll
    for (int ks = 0; ks < KS; ++ks) kf[kt][ks] = *(const bf16x8*)(sK + (kt * 32 + r) * ldk + ks * 16 + 8 * h);
  __builtin_amdgcn_sched_barrier(0);
#pragma unroll
  for (int kt = 0; kt < 2; ++kt)
#pragma unroll
    for (int j = 0; j < 16; ++j) s[kt][j] = 0.f;
#pragma unroll
  for (int ks = 0; ks < KS; ++ks)
#pragma unroll
    for (int kt = 0; kt < 2; ++kt) s[kt] = MFMA32(kf[kt][ks], qf[ks], s[kt]);
}
DI void pv32(const f32x16 (&pr)[2], const bf16_t* sVt, f32x16 (&o)[2], int lane) {
  const int r = lane & 31, h = lane >> 5;
#pragma unroll
  for (int kt = 0; kt < 2; ++kt)
#pragma unroll
    for (int st = 0; st < 2; ++st) {
      uint4 u;
      u.x = pack2(pr[kt][8 * st + 0], pr[kt][8 * st + 1]); u.y = pack2(pr[kt][8 * st + 2], pr[kt][8 * st + 3]);
      u.z = pack2(pr[kt][8 * st + 4], pr[kt][8 * st + 5]); u.w = pack2(pr[kt][8 * st + 6], pr[kt][8 * st + 7]);
      const bf16x8 pb = __builtin_bit_cast(bf16x8, u);
#pragma unroll
      for (int dt = 0; dt < 2; ++dt) {
        const bf16_t* vp = sVt + (dt * 32 + r) * LDV + kt * 32 + 16 * st + 4 * (h ^ ((r >> 4) & 1));
        const uint2 lo = *(const uint2*)vp;
        const uint2 hi = *(const uint2*)(vp + 8);
        const uint4 v4 = make_uint4(lo.x, lo.y, hi.x, hi.y);
        o[dt] = MFMA32(__builtin_bit_cast(bf16x8, v4), pb, o[dt]);
      }
    }
}
template <int MODE, bool PV, class VF>
DI void softmax32(f32x16 (&s)[2], float& m, float& l, f32x16 (&o)[2], float sl2, bool lanesel, VF valid) {
  float mx0 = MASKV, mx1 = MASKV, mx2 = MASKV, mx3 = MASKV;
#pragma unroll
  for (int kt = 0; kt < 2; ++kt)
#pragma unroll
    for (int q4 = 0; q4 < 4; ++q4) {
      if (MODE == 2) {
#pragma unroll
        for (int i = 0; i < 4; ++i) s[kt][q4 * 4 + i] = valid(kt, q4 * 4 + i) ? s[kt][q4 * 4 + i] : MASKV;
      }
      mx0 = fmaxf(mx0, s[kt][q4 * 4 + 0]); mx1 = fmaxf(mx1, s[kt][q4 * 4 + 1]);
      mx2 = fmaxf(mx2, s[kt][q4 * 4 + 2]); mx3 = fmaxf(mx3, s[kt][q4 * 4 + 3]);
    }
  float mx = fmaxf(fmaxf(mx0, mx1), fmaxf(mx2, mx3));
  if (MODE == 1) mx = lanesel ? mx : MASKV;
  mx = fmaxf(mx, __shfl_xor(mx, 32));
  const float mnew = fmaxf(m, mx * sl2);
  const float alpha = __builtin_amdgcn_exp2f(m - mnew);
  m = mnew;
  const float moff = (MODE == 1 && !lanesel) ? 1e30f : mnew;
  float r0 = 0.f, r1 = 0.f, r2 = 0.f, r3 = 0.f;
#pragma unroll
  for (int kt = 0; kt < 2; ++kt)
#pragma unroll
    for (int q4 = 0; q4 < 4; ++q4) {
      const float p0 = __builtin_amdgcn_exp2f(fmaf(s[kt][q4 * 4 + 0], sl2, -moff));
      const float p1 = __builtin_amdgcn_exp2f(fmaf(s[kt][q4 * 4 + 1], sl2, -moff));
      const float p2 = __builtin_amdgcn_exp2f(fmaf(s[kt][q4 * 4 + 2], sl2, -moff));
      const float p3 = __builtin_amdgcn_exp2f(fmaf(s[kt][q4 * 4 + 3], sl2, -moff));
      s[kt][q4 * 4 + 0] = p0; s[kt][q4 * 4 + 1] = p1; s[kt][q4 * 4 + 2] = p2; s[kt][q4 * 4 + 3] = p3;
      r0 += p0; r1 += p1; r2 += p2; r3 += p3;
    }
  l = l * alpha + ((r0 + r1) + (r2 + r3));
  if (PV) {
    if (__any(alpha != 1.f)) {
#pragma unroll
      for (int dt = 0; dt < 2; ++dt)
#pragma unroll
        for (int j = 0; j < 16; ++j) o[dt][j] *= alpha;
    }
  }
}
template <int MODE, class VF>
DI void softmax32_pk(f32x16 (&s)[2], float& m, float& l, f32x16 (&o)[2], float sl2, bool lanesel, VF valid, uint4 (&pk)[2][2]) {
  float mx0 = MASKV, mx1 = MASKV, mx2 = MASKV, mx3 = MASKV;
  float v[2][16];
#pragma unroll
  for (int kt = 0; kt < 2; ++kt)
#pragma unroll
    for (int j = 0; j < 16; ++j) v[kt][j] = (MODE == 2) ? (valid(kt, j) ? s[kt][j] : MASKV) : s[kt][j];
#pragma unroll
  for (int kt = 0; kt < 2; ++kt)
#pragma unroll
    for (int q4 = 0; q4 < 4; ++q4) {
      mx0 = fmaxf(mx0, v[kt][q4 * 4 + 0]); mx1 = fmaxf(mx1, v[kt][q4 * 4 + 1]);
      mx2 = fmaxf(mx2, v[kt][q4 * 4 + 2]); mx3 = fmaxf(mx3, v[kt][q4 * 4 + 3]);
    }
  float mx = fmaxf(fmaxf(mx0, mx1), fmaxf(mx2, mx3));
  if (MODE == 1) mx = lanesel ? mx : MASKV;
  {
    const auto sw = __builtin_amdgcn_permlane32_swap(__float_as_uint(mx), __float_as_uint(mx), false, false);
    mx = fmaxf(__uint_as_float(sw[0]), __uint_as_float(sw[1]));
  }
  constexpr float RESCALE_THR = 8.f;
  const float mxs = mx * sl2;
  float alpha = 1.f;
  if (__any(mxs > m + RESCALE_THR)) {
    asm volatile("" ::: "memory");
    const float mnew = fmaxf(m, mxs);
    alpha = __builtin_amdgcn_exp2f(m - mnew);
    m = mnew;
#pragma unroll
    for (int dt = 0; dt < 2; ++dt)
#pragma unroll
      for (int j = 0; j < 16; ++j) o[dt][j] *= alpha;
  }
  const float moff = (MODE == 1 && !lanesel) ? 1e30f : m;
  float r0 = 0.f, r1 = 0.f, r2 = 0.f, r3 = 0.f;
#pragma unroll
  for (int kt = 0; kt < 2; ++kt)
#pragma unroll
    for (int st = 0; st < 2; ++st) {
      const float p0 = __builtin_amdgcn_exp2f(fmaf(v[kt][8 * st + 0], sl2, -moff));
      const float p1 = __builtin_amdgcn_exp2f(fmaf(v[kt][8 * st + 1], sl2, -moff));
      const float p2 = __builtin_amdgcn_exp2f(fmaf(v[kt][8 * st + 2], sl2, -moff));
      const float p3 = __builtin_amdgcn_exp2f(fmaf(v[kt][8 * st + 3], sl2, -moff));
      const float p4 = __builtin_amdgcn_exp2f(fmaf(v[kt][8 * st + 4], sl2, -moff));
      const float p5 = __builtin_amdgcn_exp2f(fmaf(v[kt][8 * st + 5], sl2, -moff));
      const float p6 = __builtin_amdgcn_exp2f(fmaf(v[kt][8 * st + 6], sl2, -moff));
      const float p7 = __builtin_amdgcn_exp2f(fmaf(v[kt][8 * st + 7], sl2, -moff));
      r0 += p0 + p4; r1 += p1 + p5; r2 += p2 + p6; r3 += p3 + p7;
      pk[kt][st].x = pack2(p0, p1); pk[kt][st].y = pack2(p2, p3); pk[kt][st].z = pack2(p4, p5); pk[kt][st].w = pack2(p6, p7);
    }
  l = l * alpha + ((r0 + r1) + (r2 + r3));
}
DI void pv32_pk(const uint4 (&pk)[2][2], const bf16_t* sVt, f32x16 (&o)[2], int lane) {
  const int r = lane & 31, h = lane >> 5;
#pragma unroll
  for (int kt = 0; kt < 2; ++kt)
#pragma unroll
    for (int st = 0; st < 2; ++st) {
      const bf16x8 pb = __builtin_bit_cast(bf16x8, pk[kt][st]);
#pragma unroll
      for (int dt = 0; dt < 2; ++dt) {
        const bf16_t* vp = sVt + (dt * 32 + r) * LDV + kt * 32 + 16 * st + 4 * (h ^ ((r >> 4) & 1));
        const uint2 lo = *(const uint2*)vp;
        const uint2 hi = *(const uint2*)(vp + 8);
        const uint4 v4 = make_uint4(lo.x, lo.y, hi.x, hi.y);
        o[dt] = MFMA32(__builtin_bit_cast(bf16x8, v4), pb, o[dt]);
      }
    }
}
DI void load_vfrag(bf16x8 (&vf)[2][2], const bf16_t* sVt, int kt, int lane) {
  const int r = lane & 31, h = lane >> 5;
#pragma unroll
  for (int st = 0; st < 2; ++st)
#pragma unroll
    for (int dt = 0; dt < 2; ++dt) {
      const bf16_t* vp = sVt + (dt * 32 + r) * LDV + kt * 32 + 16 * st + 4 * (h ^ ((r >> 4) & 1));
      const uint2 lo = *(const uint2*)vp;
      const uint2 hi = *(const uint2*)(vp + 8);
      const uint4 v4 = make_uint4(lo.x, lo.y, hi.x, hi.y);
      vf[st][dt] = __builtin_bit_cast(bf16x8, v4);
    }
}
template <int MODE, class VF>
DI void softmax_pv32(f32x16 (&s)[2], float& m, float& l, f32x16 (&o)[2], float sl2, bool lanesel, VF valid, const bf16_t* sVt, int lane) {
  bf16x8 vf[2][2];
  load_vfrag(vf, sVt, 0, lane);
  float mx0 = MASKV, mx1 = MASKV, mx2 = MASKV, mx3 = MASKV;
  float v[2][16];
#pragma unroll
  for (int kt = 0; kt < 2; ++kt)
#pragma unroll
    for (int j = 0; j < 16; ++j) v[kt][j] = (MODE == 2) ? (valid(kt, j) ? s[kt][j] : MASKV) : s[kt][j];
#pragma unroll
  for (int kt = 0; kt < 2; ++kt)
#pragma unroll
    for (int q4 = 0; q4 < 4; ++q4) {
      mx0 = fmaxf(mx0, v[kt][q4 * 4 + 0]); mx1 = fmaxf(mx1, v[kt][q4 * 4 + 1]);
      mx2 = fmaxf(mx2, v[kt][q4 * 4 + 2]); mx3 = fmaxf(mx3, v[kt][q4 * 4 + 3]);
    }
  float mx = fmaxf(fmaxf(mx0, mx1), fmaxf(mx2, mx3));
  if (MODE == 1) mx = lanesel ? mx : MASKV;
  {
    const auto sw = __builtin_amdgcn_permlane32_swap(__float_as_uint(mx), __float_as_uint(mx), false, false);
    mx = fmaxf(__uint_as_float(sw[0]), __uint_as_float(sw[1]));
  }
  constexpr float RESCALE_THR = 8.f;
  const float mxs = mx * sl2;
  float alpha = 1.f;
  if (__any(mxs > m + RESCALE_THR)) {
    asm volatile("" ::: "memory");
    const float mnew = fmaxf(m, mxs);
    alpha = __builtin_amdgcn_exp2f(m - mnew);
    m = mnew;
#pragma unroll
    for (int dt = 0; dt < 2; ++dt)
#pragma unroll
      for (int j = 0; j < 16; ++j) o[dt][j] *= alpha;
  }
  const float moff = (MODE == 1 && !lanesel) ? 1e30f : m;
  float r0 = 0.f, r1 = 0.f, r2 = 0.f, r3 = 0.f;
  uint4 pk0[2], pk1[2];
  bf16x8 vf1[2][2];
#define SM_HALF(KT, PK) _Pragma("unroll") for (int st = 0; st < 2; ++st) { \
      const float p0 = __builtin_amdgcn_exp2f(fmaf(v[KT][8 * st + 0], sl2, -moff)); \
      const float p1 = __builtin_amdgcn_exp2f(fmaf(v[KT][8 * st + 1], sl2, -moff)); \
      const float p2 = __builtin_amdgcn_exp2f(fmaf(v[KT][8 * st + 2], sl2, -moff)); \
      const float p3 = __builtin_amdgcn_exp2f(fmaf(v[KT][8 * st + 3], sl2, -moff)); \
      const float p4 = __builtin_amdgcn_exp2f(fmaf(v[KT][8 * st + 4], sl2, -moff)); \
      const float p5 = __builtin_amdgcn_exp2f(fmaf(v[KT][8 * st + 5], sl2, -moff)); \
      const float p6 = __builtin_amdgcn_exp2f(fmaf(v[KT][8 * st + 6], sl2, -moff)); \
      const float p7 = __builtin_amdgcn_exp2f(fmaf(v[KT][8 * st + 7], sl2, -moff)); \
      r0 += p0 + p4; r1 += p1 + p5; r2 += p2 + p6; r3 += p3 + p7; \
      PK[st].x = pack2(p0, p1); PK[st].y = pack2(p2, p3); PK[st].z = pack2(p4, p5); PK[st].w = pack2(p6, p7); }
  SM_HALF(0, pk0)
  __builtin_amdgcn_sched_barrier(0);
  load_vfrag(vf1, sVt, 1, lane);
#pragma unroll
  for (int st = 0; st < 2; ++st)
#pragma unroll
    for (int dt = 0; dt < 2; ++dt) o[dt] = MFMA32(vf[st][dt], __builtin_bit_cast(bf16x8, pk0[st]), o[dt]);
  SM_HALF(1, pk1)
  __builtin_amdgcn_sched_group_barrier(0x100, 4, 0);
#pragma unroll
  for (int q = 0; q < 4; ++q) {
    __builtin_amdgcn_sched_group_barrier(0x008, 1, 0);
    __builtin_amdgcn_sched_group_barrier(0x002, 14, 0);
  }
  __builtin_amdgcn_sched_barrier(0);
#pragma unroll
  for (int st = 0; st < 2; ++st)
#pragma unroll
    for (int dt = 0; dt < 2; ++dt) o[dt] = MFMA32(vf1[st][dt], __builtin_bit_cast(bf16x8, pk1[st]), o[dt]);
#undef SM_HALF
  l = l * alpha + ((r0 + r1) + (r2 + r3));
}
DI float half_sum(float v) { return v + __shfl_xor(v, 32); }
DI int crow32(int reg, int h) { return (reg & 3) + 8 * (reg >> 2) + 4 * h; }

#define ISSUE_K(gK_, ldk_) { const bf16_t* gp_ = (gK_) + (size_t)lrow * (ldk_) + lcc; rk0 = *(const uint4*)gp_; rk1 = *(const uint4*)(gp_ + (size_t)32 * (ldk_)); }
#define ISSUE_V(gV_, ldv_) { const bf16_t* gp_ = (gV_) + (size_t)lrow * (ldv_) + lcc; rv0 = *(const uint4*)gp_; rv1 = *(const uint4*)(gp_ + (size_t)32 * (ldv_)); }
#define STORE_K(sK_, ldks_) { *(uint4*)((sK_) + lrow * (ldks_) + lcc) = rk0; *(uint4*)((sK_) + (lrow + 32) * (ldks_) + lcc) = rk1; }
#define STORE_V(sV_) { const bool sw_ = (lrow >> 4) & 1; \
    *(uint4*)((sV_) + lrow * LDV + lcc) = sw_ ? make_uint4(rv0.z, rv0.w, rv0.x, rv0.y) : rv0; \
    *(uint4*)((sV_) + (lrow + 32) * LDV + lcc) = sw_ ? make_uint4(rv1.z, rv1.w, rv1.x, rv1.y) : rv1; }

constexpr int LDK64 = 72;

__device__ void nsa_item(const Params& p, int b, int gk, int qt, char* smem) {
  bf16_t* sK = (bf16_t*)smem;
  bf16_t* sVt = sK + 64 * LDK;
  float* imp = (float*)(sVt + 64 * LDV);
  u64* selm = (u64*)(imp + 32 * 65);
  int tid = threadIdx.x; asm volatile("" : "+v"(tid));
  const int lane = tid & 63, wave = tid >> 6;
  const int r = lane & 31, h = lane >> 5;
  const int head = gk * 4 + wave;
  float* stash = (float*)(smem + 31104) + wave * 32 * 64 + lane;
  const int s0 = qt * 32;
  const size_t tok0 = (size_t)b * S_LEN + s0;
  const int bg = b * 2 + gk;
  const float sl2 = 0.125f * 1.4426950408889634f;
  const int sq = s0 + r;
  const bf16_t* qrow = p.P + (tok0 + r) * LDP;
  bf16x8 qf[4];
#pragma unroll
  for (int ks = 0; ks < 4; ++ks) qf[ks] = *(const bf16x8*)(qrow + head * 64 + ks * 16 + 8 * h);
  const float gate0 = bf2f(qrow[PC_GL + head * 3 + 0]);
  const float gate1 = bf2f(qrow[PC_GL + head * 3 + 1]);
  const float gate2 = bf2f(qrow[PC_GL + head * 3 + 2]);
  f32x16 o[2], s[2];
  float m, l;
  uint4 rk0, rk1, rv0, rv1;
  const int lrow = tid >> 3, lcc = (tid & 7) * 8;
  auto novalid = [](int, int) { return true; };

  __syncthreads();
  for (int i = tid; i < 32 * 65; i += 256) imp[i] = 0.f;
  const int nkt = min(3, (s0 >> 4) >> 6) + 1;
  const bf16_t* gKC = p.KC + (size_t)bg * 256 * 64;
  const bf16_t* gVC = p.VCt + (size_t)bg * 64 * 256;
  m = NEGF; l = 0.f;
  zero16x2(o);
  for (int kb = 0; kb < nkt; ++kb) {
    __syncthreads();
    ISSUE_K(gKC + (size_t)kb * 64 * 64, 64);
    STORE_K(sK, LDK64);
    __syncthreads();
    score32x<4>(qf, sK, LDK64, s, lane);
    softmax32<2, false>(s, m, l, o, sl2, true, [&](int kt, int reg) {
      return 16 * (kb * 64 + kt * 32 + crow32(reg, h)) + 31 <= sq; });
  }
  {
    const float lt = half_sum(l);
    const float linv = lt > 0.f ? 1.f / lt : 0.f;
    for (int kb = 0; kb < nkt; ++kb) {
      __syncthreads();
      ISSUE_K(gKC + (size_t)kb * 64 * 64, 64);
      ISSUE_V(gVC + kb * 64, 256);
      STORE_K(sK, LDK64);
      STORE_V(sVt);
      __syncthreads();
      score32x<4>(qf, sK, LDK64, s, lane);
#pragma unroll
      for (int kt = 0; kt < 2; ++kt)
#pragma unroll
        for (int reg = 0; reg < 16; ++reg) {
          const bool ok = 16 * (kb * 64 + kt * 32 + crow32(reg, h)) + 31 <= sq;
          s[kt][reg] = ok ? __builtin_amdgcn_exp2f(fmaf(s[kt][reg], sl2, -m)) * linv : 0.f;
        }
      for (int w = 0; w < 4; ++w) {
        if (wave == w) {
#pragma unroll
          for (int kt = 0; kt < 2; ++kt)
#pragma unroll
            for (int q4 = 0; q4 < 4; ++q4) {
              float* ip = imp + r * 65 + kb * 16 + kt * 8 + 2 * q4 + h;
              ip[0] += s[kt][q4 * 4 + 0] + s[kt][q4 * 4 + 1] + s[kt][q4 * 4 + 2] + 0.5f * s[kt][q4 * 4 + 3];
            }
          asm volatile("s_waitcnt lgkmcnt(0)" ::: "memory");
#pragma unroll
          for (int kt = 0; kt < 2; ++kt)
#pragma unroll
            for (int q4 = 0; q4 < 4; ++q4) {
              float* ip = imp + r * 65 + kb * 16 + kt * 8 + 2 * q4 + h + 1;
              ip[0] += 0.5f * s[kt][q4 * 4 + 3];
            }
        }
        __syncthreads();
      }
      pv32(s, sVt, o, lane);
    }
  }
#pragma unroll
  for (int dt = 0; dt < 2; ++dt)
#pragma unroll
    for (int j = 0; j < 16; ++j) stash[(dt * 16 + j) * 64] = gate0 * o[dt][j];

  __syncthreads();
#pragma unroll 1
  for (int i = 0; i < 8; ++i) {
    const int ti = wave * 8 + i;
    const int curt = (s0 + ti) >> 6;
    const int j = lane;
    float v = imp[ti * 65 + j];
    if (j == 0 || j == curt || j == curt - 1) v = 1.0e4f; else if (j > curt) v = -1.0e4f;
    int rank = 0;
#pragma unroll 4
    for (int jp = 0; jp <= curt; ++jp) {
      const float vj = __uint_as_float(__builtin_amdgcn_readlane(__float_as_uint(v), jp));
      rank += ((vj > v) || (vj == v && jp < j)) ? 1 : 0;
    }
    if (j > curt) rank = j;
    const u64 mask = __ballot(rank < 16);
    if (lane == 0) selm[ti] = mask;
  }
  __syncthreads();
  const u64 mysel = selm[r];
  const int cur = s0 >> 6;

  {
    m = NEGF; l = 0.f; zero16x2(o);
    const bf16_t* gK = p.P + (size_t)b * S_LEN * LDP + PC_KS + gk * 64;
    const bf16_t* gV = p.VsT + (size_t)bg * 64 * S_LEN;
    ISSUE_K(gK, LDP); ISSUE_V(gV, S_LEN);
    for (int j = 0; j <= cur; ++j) {
      __syncthreads();
      STORE_K(sK, LDK64); STORE_V(sVt);
      __syncthreads();
      if (j < cur) { ISSUE_K(gK + (size_t)(j + 1) * 64 * LDP, LDP); ISSUE_V(gV + (j + 1) * 64, S_LEN); }
      score32x<4>(qf, sK, LDK64, s, lane);
      const bool sel = (mysel >> j) & 1ull;
      if (j < cur) softmax_pv32<1>(s, m, l, o, sl2, sel, novalid, sVt, lane);
      else softmax_pv32<2>(s, m, l, o, sl2, true, [&](int kt, int reg) {
        return sel && (j * 64 + kt * 32 + crow32(reg, h) <= sq); }, sVt, lane);
    }
    const float lt = half_sum(l); const float f = (lt > 0.f ? 1.f / lt : 0.f) * gate1;
#pragma unroll
    for (int dt = 0; dt < 2; ++dt)
#pragma unroll
      for (int j = 0; j < 16; ++j) stash[(dt * 16 + j) * 64] += f * o[dt][j];
  }
  {
    m = NEGF; l = 0.f; zero16x2(o);
    const bf16_t* gK = p.P + (size_t)b * S_LEN * LDP + PC_KW + gk * 64;
    const bf16_t* gV = p.VwT + (size_t)bg * 64 * S_LEN;
    const int jlo = max(0, s0 - 511) >> 6;
    ISSUE_K(gK + (size_t)jlo * 64 * LDP, LDP); ISSUE_V(gV + jlo * 64, S_LEN);
    for (int j = jlo; j <= cur; ++j) {
      __syncthreads();
      STORE_K(sK, LDK64); STORE_V(sVt);
      __syncthreads();
      if (j < cur) { ISSUE_K(gK + (size_t)(j + 1) * 64 * LDP, LDP); ISSUE_V(gV + (j + 1) * 64, S_LEN); }
      score32x<4>(qf, sK, LDK64, s, lane);
      const bool interior = (j * 64 + 63 <= s0) && (j * 64 > s0 + 31 - 512);
      if (interior) softmax_pv32<0>(s, m, l, o, sl2, true, novalid, sVt, lane);
      else softmax_pv32<2>(s, m, l, o, sl2, true, [&](int kt, int reg) {
        const int key = j * 64 + kt * 32 + crow32(reg, h);
        return (key <= sq) && (key > sq - 512); }, sVt, lane);
    }
    const float lt = half_sum(l); const float f = (lt > 0.f ? 1.f / lt : 0.f) * gate2;
#pragma unroll
    for (int dt = 0; dt < 2; ++dt)
#pragma unroll
      for (int j = 0; j < 16; ++j) o[dt][j] = stash[(dt * 16 + j) * 64] + f * o[dt][j];
  }
  {
    const size_t tok = tok0 + r;
#pragma unroll
    for (int dt = 0; dt < 2; ++dt)
#pragma unroll
      for (int q4 = 0; q4 < 4; ++q4) {
        const int dcol = dt * 32 + 8 * q4 + 4 * h;
        const uint2 z = *(const uint2*)(p.P + tok * LDP + PC_ZN + head * 64 + dcol);
        uint2 ov;
        ov.x = pack2(o[dt][q4 * 4 + 0] * __uint_as_float(z.x << 16), o[dt][q4 * 4 + 1] * __uint_as_float(z.x & 0xffff0000u));
        ov.y = pack2(o[dt][q4 * 4 + 2] * __uint_as_float(z.y << 16), o[dt][q4 * 4 + 3] * __uint_as_float(z.y & 0xffff0000u));
        *(uint2*)(p.MIX + tok * 1024 + head * 64 + dcol) = ov;
      }
  }
}

__device__ void mla_item(const Params& p, int b, int hd, int qt, char* smem) {
  bf16_t* sK = (bf16_t*)smem;
  bf16_t* sVt = sK + 64 * LDK;
  int tid = threadIdx.x; asm volatile("" : "+v"(tid));
  const int lane = tid & 63, wave = tid >> 6;
  const int r = lane & 31, h = lane >> 5;
  const int q0 = qt * 128, sw = q0 + wave * 32;
  const size_t tokw = (size_t)b * S_LEN + sw;
  const float sl2 = 0.10206207261596577f * 1.4426950408889634f;
  const int sq = sw + r;
  bf16x8 qf[6];
  {
    const bf16_t* qrow = p.Qm + (tokw + r) * 768;
#pragma unroll
    for (int ks = 0; ks < 4; ++ks) qf[ks] = *(const bf16x8*)(qrow + hd * 64 + ks * 16 + 8 * h);
#pragma unroll
    for (int ks = 0; ks < 2; ++ks) qf[4 + ks] = *(const bf16x8*)(qrow + 512 + hd * 32 + ks * 16 + 8 * h);
  }
  f32x16 o[2], s[2];
  zero16x2(o);
  float m = NEGF, l = 0.f;
  const bf16_t* gKn = p.Kn + (size_t)b * S_LEN * 512 + hd * 64;
  const bf16_t* gKr = p.P + (size_t)b * S_LEN * LDP + PC_KR;
  const bf16_t* gV = p.VmT + (size_t)(b * 8 + hd) * 64 * S_LEN;
  const int nkt = 2 * qt + 2;
  const int kr_r = tid >> 2, kr_c = (tid & 3) * 8;
  uint4 rk0, rk1, rv0, rv1, rkr;
  const int lrow = tid >> 3, lcc = (tid & 7) * 8;
  auto novalid = [](int, int) { return true; };
  ISSUE_K(gKn, 512); ISSUE_V(gV, S_LEN);
  rkr = *(const uint4*)(gKr + (size_t)kr_r * LDP + kr_c);
  for (int kb = 0; kb < nkt; ++kb) {
    __syncthreads();
    STORE_K(sK, LDK); STORE_V(sVt);
    *(uint4*)(sK + kr_r * LDK + 64 + kr_c) = rkr;
    __syncthreads();
    if (kb + 1 < nkt) {
      ISSUE_K(gKn + (size_t)(kb + 1) * 64 * 512, 512); ISSUE_V(gV + (kb + 1) * 64, S_LEN);
      rkr = *(const uint4*)(gKr + (size_t)((kb + 1) * 64 + kr_r) * LDP + kr_c);
    }
    if (kb * 64 <= sw + 31) {
      score32x<6>(qf, sK, LDK, s, lane);
      if (kb * 64 + 63 <= sw) softmax_pv32<0>(s, m, l, o, sl2, true, novalid, sVt, lane);
      else softmax_pv32<2>(s, m, l, o, sl2, true, [&](int kt, int reg) {
        return kb * 64 + kt * 32 + crow32(reg, h) <= sq; }, sVt, lane);
    }
  }
  {
    const float lt = half_sum(l); const float f = lt > 0.f ? 1.f / lt : 0.f;
    const size_t tok = tokw + r;
#pragma unroll
    for (int dt = 0; dt < 2; ++dt)
#pragma unroll
      for (int q4 = 0; q4 < 4; ++q4) {
        const int dcol = dt * 32 + 8 * q4 + 4 * h;
        const uint2 z = *(const uint2*)(p.P + tok * LDP + PC_ZM + hd * 64 + dcol);
        uint2 ov;
        ov.x = pack2(o[dt][q4 * 4 + 0] * f * __uint_as_float(z.x << 16), o[dt][q4 * 4 + 1] * f * __uint_as_float(z.x & 0xffff0000u));
        ov.y = pack2(o[dt][q4 * 4 + 2] * f * __uint_as_float(z.y << 16), o[dt][q4 * 4 + 3] * f * __uint_as_float(z.y & 0xffff0000u));
        *(uint2*)(p.MIX + tok * 1024 + 512 + hd * 64 + dcol) = ov;
      }
  }
}

#define XB_QUEUE(j) (3456 + 2 * 4096 + 64 * (j))
#define XB_KCDONE (3456 + 2 * 4096 + 64 * 8)
__device__ void phase3(const Params& p, char* smem) {
  volatile unsigned* slot = (volatile unsigned*)(smem + SMEM_BYTES - 16);
  for (int it = blockIdx.x; it < 32; it += gridDim.x) {
    compress_finish_item(p, it & 1, (it >> 1) & 3, (it >> 3) & 1, (it >> 4) & 1, smem);
    asm volatile("s_waitcnt vmcnt(0)" ::: "memory");
    __syncthreads();
    if (threadIdx.x == 0) {
      __builtin_amdgcn_fence(__ATOMIC_RELEASE, "agent");
      asm volatile("s_waitcnt vmcnt(0)" ::: "memory");
      __hip_atomic_fetch_add(p.bar + XB_KCDONE, 1u, __ATOMIC_RELAXED, __HIP_MEMORY_SCOPE_AGENT);
    }
  }
  bool kc_ready = false;
  const unsigned myx = (unsigned)__builtin_amdgcn_s_getreg((3 << 11) | 20) & 7u;
#pragma unroll 1
  for (unsigned k = 0; k < 8; ++k) {
    const unsigned xq = (myx + k) & 7u;
#pragma unroll 1
    for (;;) {
      __syncthreads();
      if (threadIdx.x == 0) *slot = __hip_atomic_fetch_add(p.bar + XB_QUEUE(xq), 1u, __ATOMIC_RELAXED, __HIP_MEMORY_SCOPE_AGENT);
      __syncthreads();
      const unsigned q = *slot;
      if (q >= 256u) break;
      const unsigned code = p.order[q];
      if (code & 128u) {
        if (!kc_ready) {
          if (threadIdx.x == 0) {
            unsigned spins = 0;
            while (__hip_atomic_load(p.bar + XB_KCDONE, __ATOMIC_RELAXED, __HIP_MEMORY_SCOPE_AGENT) < 32u) {
              __builtin_amdgcn_s_sleep(2);
              if (++spins > (1u << 22)) break;
            }
            __builtin_amdgcn_fence(__ATOMIC_ACQUIRE, "agent");
            asm volatile("s_waitcnt vmcnt(0)" ::: "memory");
          }
          __syncthreads();
          kc_ready = true;
        }
        nsa_item(p, xq & 3, xq >> 2, code & 127u, smem);
      } else { const int pid = xq + 8 * ((code >> 5) & 3); mla_item(p, pid & 3, pid >> 2, code & 31u, smem); }
    }
  }
}

DI void p4_epilogue(const Params& p, f32x4 (&acc)[4][4], int m0, int cb, int lane, float* stg) {
  const int c = lane & 15, g = lane >> 4;
  const int b = m0 / S_LEN;
  const int rl = lane >> 4, col = (lane & 15) * 4;
  const float4 gt = *(const float4*)(p.gatef + b * 1024 + cb + col);
#pragma unroll
  for (int hf = 0; hf < 2; ++hf) {
#pragma unroll
    for (int mi2 = 0; mi2 < 2; ++mi2)
#pragma unroll
      for (int ni = 0; ni < 4; ++ni)
#pragma unroll
        for (int r = 0; r < 4; ++r) stg[(mi2 * 16 + g * 4 + r) * 68 + ni * 16 + c] = acc[hf * 2 + mi2][ni][r];
    asm volatile("s_waitcnt lgkmcnt(0)" ::: "memory");
#pragma unroll
    for (int i = 0; i < 8; ++i) {
      const float4 a = *(const float4*)(stg + (i * 4 + rl) * 68 + col);
      const size_t off = (size_t)(m0 + hf * 32 + i * 4 + rl) * 1024 + cb + col;
      const float4 xv = *(const float4*)(p.x + off);
      float4 o; o.x = xv.x + gt.x * a.x; o.y = xv.y + gt.y * a.y; o.z = xv.z + gt.z * a.z; o.w = xv.w + gt.w * a.w;
      *(float4*)(p.out + off) = o;
    }
    asm volatile("s_waitcnt lgkmcnt(0)" ::: "memory");
  }
}
__device__ void phase4(const Params& p, char* smem) {
  const int xcd = blockIdx.x & 7, lid = blockIdx.x >> 3, nl = (gridDim.x - xcd + 7) >> 3;
  for (int t = lid; t < 64; t += nl) {
    int tid = threadIdx.x; asm volatile("" : "+v"(tid)); const int lane = tid & 63, wave = tid >> 6, wm = wave >> 1, wn = wave & 1;
    const int mt = xcd * 8 + (t >> 3), nt = t & 7;
    f32x4 accA[4][4], accB[4][4]; zero_acc44(accA); zero_acc44(accB);
    const bf16_t* A = p.MIX + (size_t)mt * 256 * 1024;
    const bf16_t* B = p.WoutT + (size_t)nt * 128 * 1024;
    gemm256(accA, accB, 1024,
            [&](int r, int k) { return *(const uint4*)(A + (size_t)r * 1024 + k); },
            [&](int r, int k) { return *(const uint4*)(B + (size_t)r * 1024 + k); }, (bf16_t*)smem);
    __syncthreads();
    float* stg = (float*)smem + wave * (32 * 68);
    p4_epilogue(p, accA, mt * 256 + wm * 128, nt * 128 + wn * 64, lane, stg);
    p4_epilogue(p, accB, mt * 256 + wm * 128 + 64, nt * 128 + wn * 64, lane, stg);
  }
}
__device__ void phase5(const Params& p) {
  int tid = threadIdx.x; asm volatile("" : "+v"(tid)); const int lane = tid & 63, wave = tid >> 6;
  for (int row = blockIdx.x * 4 + wave; row < T_TOK; row += gridDim.x * 4) {
    float4* yr = (float4*)(p.out + (size_t)row * 1024);
    const float4* gr = (const float4*)p.final_g;
    float4 v[4]; float ss = 0.f;
#pragma unroll
    for (int i = 0; i < 4; ++i) { v[i] = yr[i * 64 + lane]; ss += v[i].x * v[i].x + v[i].y * v[i].y + v[i].z * v[i].z + v[i].w * v[i].w; }
    ss = wave_sum(ss);
    const float rstd = rsqrtf(ss * (1.f / 1024.f) + 1e-6f);
#pragma unroll
    for (int i = 0; i < 4; ++i) {
      const float4 gg = gr[i * 64 + lane];
      float4 o; o.x = v[i].x * rstd * gg.x; o.y = v[i].y * rstd * gg.y; o.z = v[i].z * rstd * gg.z; o.w = v[i].w * rstd * gg.w;
      yr[i * 64 + lane] = o;
    }
  }
}

#define XB_TMO      128
#define XB_XCNT(j)  (256  + 64 * (j))
#define XB_XSUB(j)  (1280 + 64 * (j))
#define XB_XGEN(j)  (2304 + 64 * (j))
#define XB_TOP      3328
#define XB_TOPGEN   3392
#define XCD_BAR_WORDS 3456
#define XB_SPIN_CAP (1u << 18)
#define LAS __attribute__((address_space(3)))
DI unsigned xb_ld(unsigned* p) { return __hip_atomic_load(p, __ATOMIC_RELAXED, __HIP_MEMORY_SCOPE_AGENT); }
DI unsigned xb_add(unsigned* p, unsigned v) { return __hip_atomic_fetch_add(p, v, __ATOMIC_RELAXED, __HIP_MEMORY_SCOPE_AGENT); }
DI unsigned xb_xcc_id() { return (unsigned)__builtin_amdgcn_s_getreg((3 << 11) | 20) & 0xFu; }
#define XB_SPIN(cond, bar) do { unsigned _sp = 0; while (cond) { __builtin_amdgcn_s_sleep(1); \
    if ((++_sp & 255u) == 0u) { if (xb_ld(&(bar)[XB_TMO])) break; if (_sp > XB_SPIN_CAP) { atomicAdd(&(bar)[XB_TMO], 1u); break; } } } } while (0)
struct XcdBarrier { unsigned* bar; unsigned x; unsigned* st; };
DI XcdBarrier xcd_barrier_post(unsigned* bar, unsigned* st) {
  XcdBarrier b; b.bar = bar; b.x = xb_xcc_id(); b.st = st;
  if (threadIdx.x == 0) (void)xb_add(&bar[XB_XCNT(b.x)], 1u);
  return b;
}
DI void xcd_barrier_complete(unsigned* bar, unsigned x, unsigned& nloc, unsigned& nx) {
  const unsigned G = gridDim.x * gridDim.y * gridDim.z;
  unsigned sum, cnt, mine, sp = 0u;
  for (;;) {
    sum = 0u; cnt = 0u; mine = 0u;
#pragma unroll
    for (unsigned j = 0; j < 16; ++j) { const unsigned c = xb_ld(&bar[XB_XCNT(j)]); sum += c; cnt += (c > 0u) ? 1u : 0u; mine = (j == x) ? c : mine; }
    if (sum == G) break;
    __builtin_amdgcn_s_sleep(1);
    if ((++sp & 255u) == 0u) { if (xb_ld(&bar[XB_TMO])) break; if (sp > XB_SPIN_CAP) { atomicAdd(&bar[XB_TMO], 1u); break; } }
  }
  nloc = mine > 0u ? mine : 1u; nx = cnt > 0u ? cnt : 1u;
}
DI void xcd_barrier(const XcdBarrier& b) {
  asm volatile("s_waitcnt vmcnt(0)" ::: "memory");
  __syncthreads();
  if (threadIdx.x == 0) {
    unsigned* bar = b.bar;
    __builtin_amdgcn_s_waitcnt(0);
    unsigned nloc = b.st[0], nx = b.st[1];
    if (nloc == 0u) { xcd_barrier_complete(bar, b.x, nloc, nx); b.st[0] = nloc; b.st[1] = nx; }
    const unsigned old = xb_add(&bar[XB_XSUB(b.x)], 1u);
    const unsigned gen = old / nloc;
    if (old + 1u == (gen + 1u) * nloc) {
      __builtin_amdgcn_fence(__ATOMIC_RELEASE, "agent");
      asm volatile("s_waitcnt vmcnt(0)" ::: "memory");
      const unsigned og = xb_add(&bar[XB_TOP], 1u);
      const unsigned tg = og / nx;
      if (og + 1u == (tg + 1u) * nx) xb_add(&bar[XB_TOPGEN], 1u);
      else XB_SPIN(xb_ld(&bar[XB_TOPGEN]) == tg, bar);
      __builtin_amdgcn_fence(__ATOMIC_ACQUIRE, "agent");
      xb_add(&bar[XB_XGEN(b.x)], 1u);
      asm volatile("s_waitcnt vmcnt(0)" ::: "memory");
    } else {
      XB_SPIN(xb_ld(&bar[XB_XGEN(b.x)]) == gen, bar);
      __builtin_amdgcn_fence(__ATOMIC_ACQUIRE, "agent");
      asm volatile("s_waitcnt vmcnt(0)" ::: "memory");
    }
  }
  __syncthreads();
}

__global__ void __launch_bounds__(256, 2) hymba_megakernel(Params p) {
  __shared__ __attribute__((aligned(16))) char smem[SMEM_BYTES];
  cg::grid_group grid = cg::this_grid();
#ifndef REP
#define REP 0
#endif
  if (p.bar == nullptr) { grid.sync(); return; }
  unsigned* st = p.bar + XCD_BAR_WORDS + 2 * blockIdx.x;
  XcdBarrier xb = xcd_barrier_post(p.bar, st);
#define GRID_SEAM() xcd_barrier(xb)
  prep_items<true>(p, smem); GRID_SEAM();
  phase1a(p, smem); GRID_SEAM();
  phase1b(p, smem); GRID_SEAM();
  phase2(p, smem); GRID_SEAM();
  phase3(p, smem); GRID_SEAM();
  phase4(p, smem); GRID_SEAM();
  phase5(p);
}

extern "C" void kernel_launch(void* const* d_in, const int* in_sizes, int n_in, void* d_out, int out_size, void* d_ws,
                              size_t ws_size, hipStream_t stream) {
  static int grid_blocks = 0;
  static int cus_static = 0;
  if (!cus_static) {
    int dev = 0, cus = 0;
    (void)hipGetDevice(&dev);
    (void)hipDeviceGetAttribute(&cus, hipDeviceAttributeMultiprocessorCount, dev);
    cus_static = cus > 0 ? cus : 256;
  }
  Params p{};
  p.x = (const float*)d_in[0]; p.c = (const float*)d_in[1]; p.pos = (const int*)d_in[2];
  p.ada_w = (const float*)d_in[3]; p.ada_b = (const float*)d_in[4]; p.norm_g = (const float*)d_in[5];
  p.w_in = (const float*)d_in[6]; p.cmp_pos = (const float*)d_in[7]; p.cmp_k_w1 = (const float*)d_in[8];
  p.cmp_k_w2 = (const float*)d_in[9]; p.cmp_v_w1 = (const float*)d_in[10]; p.cmp_v_w2 = (const float*)d_in[11];
  p.q_norm_g = (const float*)d_in[12]; p.w_q_up = (const float*)d_in[13]; p.kv_norm_g = (const float*)d_in[14];
  p.w_kv_up = (const float*)d_in[15]; p.w_out = (const float*)d_in[16]; p.final_g = (const float*)d_in[17];
  p.out = (float*)d_out;
  char* w = (char*)d_ws; size_t off = 0;
  auto take = [&](size_t bytes) { char* r = w + off; off += (bytes + 255) & ~(size_t)255; return r; };
  p.WinT = (bf16_t*)take((size_t)NPADW * 1024 * 2);
  p.WoutT = (bf16_t*)take((size_t)1024 * 1024 * 2);
  p.WqT = (bf16_t*)take((size_t)768 * 256 * 2);
  p.WkvT = (bf16_t*)take((size_t)1024 * 128 * 2);
  p.W1kT = (bf16_t*)take((size_t)128 * 2048 * 2);
  p.W1vT = (bf16_t*)take((size_t)128 * 2048 * 2);
  p.W2kT = (bf16_t*)take((size_t)64 * 128 * 2);
  p.W2vT = (bf16_t*)take((size_t)64 * 128 * 2);
  p.bar = (unsigned*)take((size_t)(XCD_BAR_WORDS + 2 * 4096 + 64 * 10) * 4);
  p.modp = (float*)take((size_t)16 * 4 * 3072 * 4);
  p.gatef = (float*)take((size_t)4096 * 4);
  p.cbp = (float*)take((size_t)2 * 8 * 128 * 4);
  p.cpart = (float*)take((size_t)256 * 16384 * 4);
  p.cs64 = (float2*)take((size_t)T_TOK * 32 * 8);
  p.cs32 = (float2*)take((size_t)T_TOK * 16 * 8);
  p.H = (bf16_t*)take((size_t)T_TOK * 1024 * 2);
  p.MIX = p.H;
  p.P = (bf16_t*)take((size_t)T_TOK * LDP * 2);
  p.VsT = (bf16_t*)take((size_t)4 * 2 * 64 * S_LEN * 2);
  p.VwT = (bf16_t*)take((size_t)4 * 2 * 64 * S_LEN * 2);
  p.ssq = (float*)take((size_t)T_TOK * 8 * 4);
  p.Qm = (bf16_t*)take((size_t)T_TOK * 768 * 2);
  p.Kn = (bf16_t*)take((size_t)T_TOK * 512 * 2);
  p.VmT = (bf16_t*)take((size_t)4 * 8 * 64 * S_LEN * 2);
  p.KC = (bf16_t*)take((size_t)8 * 256 * 64 * 2);
  p.VCt = (bf16_t*)take((size_t)8 * 64 * 256 * 2);
  for (int i = 0; i < 32; ++i) p.inv64[i] = pow(10000.0, -(double)i / 32.0);
  for (int i = 0; i < 16; ++i) p.inv32[i] = pow(10000.0, -(double)i / 16.0);
  {
    double cost[256]; unsigned char code[256];
    for (int r = 0; r < 4; ++r) for (int qt = 0; qt < 32; ++qt) { cost[r * 32 + qt] = 1.0 * (2 * qt + 2) + 1.0; code[r * 32 + qt] = (unsigned char)((r << 5) | qt); }
    for (int t = 0; t < 128; ++t) {
      const double win = (t / 2 + 1) < 9.5 ? (t / 2 + 1) : 9.5;
      cost[128 + t] = 1.25 * ((t / 2 + 1) + win + 2.0 * (t / 32 + 1)) + 6.0; code[128 + t] = (unsigned char)(128 | t);
    }
    for (int i = 0; i < 256; ++i) {
      int best = i;
      for (int j = i + 1; j < 256; ++j) if (cost[j] > cost[best]) best = j;
      const double tc = cost[i]; cost[i] = cost[best]; cost[best] = tc;
      const unsigned char tk = code[i]; code[i] = code[best]; code[best] = tk;
    }
    unsigned char ord[256]; bool used[256]; int n = 0, nm = 0;
    for (int i = 0; i < 256; ++i) used[i] = false;
    for (int i = 0; i < 256 && nm < 64; ++i) if (!(code[i] & 128)) { ord[n++] = code[i]; used[i] = true; ++nm; }
    for (int i = 0; i < 256; ++i) if (!used[i]) ord[n++] = code[i];
    for (int i = 0; i < 256; ++i) p.order[i] = ord[i];
  }
  void* args[] = {&p};
  (void)hipMemsetAsync(p.bar, 0, (size_t)(XCD_BAR_WORDS + 2 * 4096 + 64 * 10) * 4, stream);
  if (!grid_blocks) {
    hipError_t e = hipLaunchCooperativeKernel((void*)hymba_megakernel, dim3(cus_static * 2), dim3(256), args, 0, stream);
    if (e == hipSuccess) { grid_blocks = cus_static * 2; return; }
    (void)hipGetLastError();
    grid_blocks = cus_static;
  }
  hipError_t e = hipLaunchCooperativeKernel((void*)hymba_megakernel, dim3(grid_blocks), dim3(256), args, 0, stream);
  if (e != hipSuccess) fprintf(stderr, "cooperative launch failed: %s (grid %d)\n", hipGetErrorString(e), grid_blocks);
}
```

```cpp
#include <hip/hip_runtime.h>
#include <hip/hip_cooperative_groups.h>
#include <cmath>
#include <cstdio>
namespace cg = cooperative_groups;

typedef unsigned short bf16_t;
typedef __attribute__((ext_vector_type(8))) short bf16x8;
typedef __attribute__((ext_vector_type(4))) float f32x4;
typedef unsigned long long u64;

#define DI __device__ __forceinline__
#define MFMA16(a, b, c) __builtin_amdgcn_mfma_f32_16x16x32_bf16((a), (b), (c), 0, 0, 0)

constexpr int T_TOK = 16384, S_LEN = 4096;
constexpr int LDP = 2752;
constexpr int NPADW = 2816;
constexpr int PC_KC = 512, PC_VC = 640, PC_KS = 768, PC_KW = 1024, PC_ZN = 1280, PC_CQ = 1792,
              PC_CKV = 2048, PC_ZM = 2176, PC_KR = 2688, PC_GL = 2720;
constexpr float NEGF = -1e30f;
constexpr int SMEM_BYTES = 65536;
constexpr int LDK = 104;
constexpr int LDV = 72;

struct Params {
  const float* x; const float* c; const int* pos; const float* ada_w; const float* ada_b; const float* norm_g;
  const float* w_in; const float* cmp_pos; const float* cmp_k_w1; const float* cmp_k_w2; const float* cmp_v_w1;
  const float* cmp_v_w2; const float* q_norm_g; const float* w_q_up; const float* kv_norm_g; const float* w_kv_up;
  const float* w_out; const float* final_g;
  float* out;
  bf16_t *WinT, *WoutT, *WqT, *WkvT, *W1kT, *W1vT, *W2kT, *W2vT;
  float *modp, *gatef, *cbp, *cpart; float2 *cs64, *cs32;
  unsigned* bar; bf16_t *H, *P, *VsT, *VwT; float* ssq; bf16_t *Qm, *Kn, *VmT, *KC, *VCt, *MIX;
  double inv64[32]; double inv32[16];
  unsigned char order[256];
};

DI float4 ld_nt(const float4* p) { const f32x4 v = __builtin_nontemporal_load((const f32x4*)p); return make_float4(v[0], v[1], v[2], v[3]); }
DI void st_nt(float4* p, float4 v) { const f32x4 t = {v.x, v.y, v.z, v.w}; __builtin_nontemporal_store(t, (f32x4*)p); }
DI float bf2f(bf16_t v) { return __uint_as_float(((unsigned)v) << 16); }
typedef __bf16 bf16x2_t __attribute__((ext_vector_type(2)));
typedef float f32x2_t __attribute__((ext_vector_type(2)));
DI unsigned pack2(float a, float b) { const f32x2_t v = {a, b}; return __builtin_bit_cast(unsigned, __builtin_convertvector(v, bf16x2_t)); }
DI bf16_t f2bf(float a) { return (bf16_t)(pack2(a, a) & 0xffffu); }
DI float wave_sum(float v) {
  v += __shfl_xor(v, 32); v += __shfl_xor(v, 16); v += __shfl_xor(v, 8);
  v += __shfl_xor(v, 4); v += __shfl_xor(v, 2); v += __shfl_xor(v, 1); return v;
}
DI void zero_acc44(f32x4 (&a)[4][4]) {
#pragma unroll
  for (int i = 0; i < 4; ++i)
#pragma unroll
    for (int j = 0; j < 4; ++j) a[i][j] = f32x4{0.f, 0.f, 0.f, 0.f};
}
DI void zero_acc42(f32x4 (&a)[4][2]) {
#pragma unroll
  for (int i = 0; i < 4; ++i)
#pragma unroll
    for (int j = 0; j < 2; ++j) a[i][j] = f32x4{0.f, 0.f, 0.f, 0.f};
}

template <class FA, class FB>
DI void gemm128(f32x4 (&acc)[4][4], int K, FA loadA, FB loadB, bf16_t* sbase) {
  int tid = threadIdx.x; asm volatile("" : "+v"(tid)); const int lane = tid & 63, wave = tid >> 6;
  const int wm = wave >> 1, wn = wave & 1;
  const int lr = tid >> 3, lc = (tid & 7) * 8;
  const int c = lane & 15, g = lane >> 4;
  const int wsw = (((tid & 7) ^ ((lr >> 1) & 7)) << 3);
  const int rsw = (c >> 1) & 7;
  const int nk = K >> 6;
  uint4 ra[4], rb[4];
#pragma unroll
  for (int p = 0; p < 4; ++p) { ra[p] = loadA(lr + 32 * p, lc); rb[p] = loadB(lr + 32 * p, lc); }
  __syncthreads();
#pragma unroll
  for (int p = 0; p < 4; ++p) {
    *(uint4*)(sbase + (lr + 32 * p) * 64 + wsw) = ra[p];
    *(uint4*)(sbase + 8192 + (lr + 32 * p) * 64 + wsw) = rb[p];
  }
  if (nk > 1) {
#pragma unroll
    for (int p = 0; p < 4; ++p) { ra[p] = loadA(lr + 32 * p, 64 + lc); rb[p] = loadB(lr + 32 * p, 64 + lc); }
  }
  for (int it = 0; it < nk; ++it) {
    bf16_t* sA = sbase + (it & 1) * 16384;
    bf16_t* sB = sA + 8192;
    bf16_t* nA = sbase + ((it & 1) ^ 1) * 16384;
    __syncthreads();
    if (it + 1 < nk) {
#pragma unroll
      for (int p = 0; p < 4; ++p) {
        *(uint4*)(nA + (lr + 32 * p) * 64 + wsw) = ra[p];
        *(uint4*)(nA + 8192 + (lr + 32 * p) * 64 + wsw) = rb[p];
      }
      if (it + 2 < nk) {
        const int k2 = (it + 2) * 64 + lc;
#pragma unroll
        for (int p = 0; p < 4; ++p) { ra[p] = loadA(lr + 32 * p, k2); rb[p] = loadB(lr + 32 * p, k2); }
      }
    }
#pragma unroll
    for (int ks = 0; ks < 2; ++ks) {
      bf16x8 af[4], bfr[4];
#pragma unroll
      for (int mi = 0; mi < 4; ++mi) af[mi] = *(const bf16x8*)(sA + (wm * 64 + mi * 16 + c) * 64 + (((ks * 4 + g) ^ rsw) << 3));
#pragma unroll
      for (int ni = 0; ni < 4; ++ni) bfr[ni] = *(const bf16x8*)(sB + (wn * 64 + ni * 16 + c) * 64 + (((ks * 4 + g) ^ rsw) << 3));
#pragma unroll
      for (int mi = 0; mi < 4; ++mi)
#pragma unroll
        for (int ni = 0; ni < 4; ++ni) acc[mi][ni] = MFMA16(af[mi], bfr[ni], acc[mi][ni]);
    }
  }
}

template <class FA, class FB>
DI void gemm256(f32x4 (&accA)[4][4], f32x4 (&accB)[4][4], int K, FA loadA, FB loadB, bf16_t* sbase) {
  int tid = threadIdx.x; asm volatile("" : "+v"(tid)); const int lane = tid & 63, wave = tid >> 6;
  const int wm = wave >> 1, wn = wave & 1;
  const int lr = tid >> 3, lc = (tid & 7) * 8;
  const int c = lane & 15, g = lane >> 4;
  const int wsw = (((tid & 7) ^ ((lr >> 1) & 7)) << 3);
  const int rsw = (c >> 1) & 7;
  bf16_t* sA = sbase; bf16_t* sB = sbase + 256 * 64;
  uint4 ra[8], rb[4];
#pragma unroll
  for (int p = 0; p < 8; ++p) ra[p] = loadA(lr + 32 * p, lc);
#pragma unroll
  for (int p = 0; p < 4; ++p) rb[p] = loadB(lr + 32 * p, lc);
  for (int k0 = 0; k0 < K; k0 += 64) {
    __syncthreads();
#pragma unroll
    for (int p = 0; p < 8; ++p) *(uint4*)(sA + (lr + 32 * p) * 64 + wsw) = ra[p];
#pragma unroll
    for (int p = 0; p < 4; ++p) *(uint4*)(sB + (lr + 32 * p) * 64 + wsw) = rb[p];
    __syncthreads();
    if (k0 + 64 < K) {
#pragma unroll
      for (int p = 0; p < 8; ++p) ra[p] = loadA(lr + 32 * p, k0 + 64 + lc);
#pragma unroll
      for (int p = 0; p < 4; ++p) rb[p] = loadB(lr + 32 * p, k0 + 64 + lc);
    }
#pragma unroll
    for (int ks = 0; ks < 2; ++ks) {
      const int ko = (((ks * 4 + g) ^ rsw) << 3);
      bf16x8 bfr[4], af0[4], af1[4];
#pragma unroll
      for (int ni = 0; ni < 4; ++ni) bfr[ni] = *(const bf16x8*)(sB + (wn * 64 + ni * 16 + c) * 64 + ko);
#pragma unroll
      for (int mi = 0; mi < 4; ++mi) af0[mi] = *(const bf16x8*)(sA + (wm * 128 + mi * 16 + c) * 64 + ko);
#pragma unroll
      for (int mi = 0; mi < 4; ++mi) af1[mi] = *(const bf16x8*)(sA + (wm * 128 + 64 + mi * 16 + c) * 64 + ko);
      __builtin_amdgcn_sched_barrier(0);
#pragma unroll
      for (int mi = 0; mi < 4; ++mi)
#pragma unroll
        for (int ni = 0; ni < 4; ++ni) accA[mi][ni] = MFMA16(af0[mi], bfr[ni], accA[mi][ni]);
#pragma unroll
      for (int mi = 0; mi < 4; ++mi)
#pragma unroll
        for (int ni = 0; ni < 4; ++ni) accB[mi][ni] = MFMA16(af1[mi], bfr[ni], accB[mi][ni]);
      __builtin_amdgcn_sched_barrier(0);
    }
  }
}

DI int mapcol(int mode, int p) {
  if (mode == 0) return p;
  if (mode == 1) {
    if (p < 1280) return p;
    if (p < 1792) return 1304 + (p - 1280);
    if (p < 2048) return 1816 + (p - 1792);
    if (p < 2176) return 2072 + (p - 2048);
    if (p < 2688) return 2232 + (p - 2176);
    if (p < 2720) return 2200 + (p - 2688);
    if (p < 2744) return 1280 + (p - 2720);
    return -1;
  }
  if (mode == 2) {
    if (p < 512) return (p >> 6) * 96 + (p & 63);
    int q = p - 512; return (q >> 5) * 96 + 64 + (q & 31);
  }
  if (p < 512) return (p >> 6) * 128 + (p & 63);
  int q = p - 512; return (q >> 6) * 128 + 64 + (q & 63);
}

DI void tr_tile(const float* __restrict__ src, int Nsrc, int K, bf16_t* __restrict__ dst, int k0, int n0, int mode,
                const float* __restrict__ scale, float* tile) {
  int tid = threadIdx.x; asm volatile("" : "+v"(tid)); const int tx = tid & 63, ty = tid >> 6;
  const int sc = mapcol(mode, n0 + tx);
  float v[16];
#pragma unroll
  for (int i = 0; i < 16; ++i) {
    const int kk = ty + 4 * i;
    v[i] = 0.f;
    if (sc >= 0) { v[i] = src[(size_t)(k0 + kk) * Nsrc + sc]; if (scale) v[i] *= scale[k0 + kk]; }
  }
  __syncthreads();
#pragma unroll
  for (int i = 0; i < 16; ++i) tile[(ty + 4 * i) * 65 + tx] = v[i];
  __syncthreads();
#pragma unroll
  for (int i = 0; i < 16; ++i) { const int nn = ty + 4 * i; dst[(size_t)(n0 + nn) * K + k0 + tx] = f2bf(tile[tx * 65 + nn]); }
}

template <bool MOD>
__device__ void prep_items(const Params& p, char* smem) {
  float* tile = (float*)smem;
  int tid = threadIdx.x; asm volatile("" : "+v"(tid));
  constexpr int N_MOD = 192, N_TR = 1172, N_CB = 16;
  for (int it = MOD ? blockIdx.x : N_MOD + blockIdx.x; it < (MOD ? N_MOD : N_MOD + N_TR + N_CB); it += gridDim.x) {
    if (it >= N_MOD && it < N_MOD + N_CB) {
      const int t = it - N_MOD, which = t >> 3, kc = t & 7;
      const float* w1 = which ? p.cmp_v_w1 : p.cmp_k_w1;
      const int hid = tid & 127, hf = tid >> 7;
      float a0 = 0.f, a1 = 0.f, a2 = 0.f, a3 = 0.f;
      const int kb0 = kc * 256 + hf * 128;
#pragma unroll 4
      for (int k = 0; k < 128; k += 4) {
        a0 += p.cmp_pos[kb0 + k] * w1[(size_t)(kb0 + k) * 128 + hid];
        a1 += p.cmp_pos[kb0 + k + 1] * w1[(size_t)(kb0 + k + 1) * 128 + hid];
        a2 += p.cmp_pos[kb0 + k + 2] * w1[(size_t)(kb0 + k + 2) * 128 + hid];
        a3 += p.cmp_pos[kb0 + k + 3] * w1[(size_t)(kb0 + k + 3) * 128 + hid];
      }
      const float a = (a0 + a1) + (a2 + a3);
      __syncthreads();
      tile[tid] = a;
      __syncthreads();
      if (tid < 128) p.cbp[(which * 8 + kc) * 128 + tid] = tile[tid] + tile[tid + 128];
    } else if (it < N_MOD) {
      const int nt = it % 12, kc = it / 12;
      __syncthreads();
      { const int b = tid >> 6, k = tid & 63; const float v = p.c[b * 1024 + kc * 64 + k]; tile[tid] = v / (1.f + expf(-v)); }
      __syncthreads();
      const int n = nt * 256 + tid;
      float a0 = 0.f, a1 = 0.f, a2 = 0.f, a3 = 0.f;
#pragma unroll 16
      for (int k = 0; k < 64; ++k) {
        const float w = p.ada_w[(size_t)(kc * 64 + k) * 3072 + n];
        a0 += tile[k] * w; a1 += tile[64 + k] * w; a2 += tile[128 + k] * w; a3 += tile[192 + k] * w;
      }
      p.modp[(kc * 4 + 0) * 3072 + n] = a0; p.modp[(kc * 4 + 1) * 3072 + n] = a1;
      p.modp[(kc * 4 + 2) * 3072 + n] = a2; p.modp[(kc * 4 + 3) * 3072 + n] = a3;
    } else {
      int t = it - N_MOD - N_CB;
      if (t < 704) { tr_tile(p.w_in, 2744, 1024, p.WinT, (t / 44) * 64, (t % 44) * 64, 1, nullptr, tile); continue; }
      t -= 704;
      if (t < 256) { tr_tile(p.w_out, 1024, 1024, p.WoutT, (t / 16) * 64, (t % 16) * 64, 0, nullptr, tile); continue; }
      t -= 256;
      if (t < 48) { tr_tile(p.w_q_up, 768, 256, p.WqT, (t / 12) * 64, (t % 12) * 64, 2, p.q_norm_g, tile); continue; }
      t -= 48;
      if (t < 32) { tr_tile(p.w_kv_up, 1024, 128, p.WkvT, (t / 16) * 64, (t % 16) * 64, 3, p.kv_norm_g, tile); continue; }
      t -= 32;
      if (t < 64) { tr_tile(p.cmp_k_w1, 128, 2048, p.W1kT, (t / 2) * 64, (t % 2) * 64, 0, nullptr, tile); continue; }
      t -= 64;
      if (t < 64) { tr_tile(p.cmp_v_w1, 128, 2048, p.W1vT, (t / 2) * 64, (t % 2) * 64, 0, nullptr, tile); continue; }
      t -= 64;
      if (t < 2) { tr_tile(p.cmp_k_w2, 64, 128, p.W2kT, t * 64, 0, 0, nullptr, tile); continue; }
      t -= 2;
      tr_tile(p.cmp_v_w2, 64, 128, p.W2vT, t * 64, 0, 0, nullptr, tile);
    }
  }
  if (MOD) return;
  double* sinv = (double*)smem;
  __syncthreads();
  if (tid < 32) sinv[tid] = p.inv64[tid]; else if (tid < 48) sinv[tid] = p.inv32[tid - 32];
  __syncthreads();
  for (int idx = blockIdx.x * 256 + tid; idx < T_TOK * 48; idx += gridDim.x * 256) {
    const int tok = idx / 48, e = idx % 48;
    const double inv = sinv[e];
    double rev = (double)p.pos[tok] * inv * 0.15915494309189535;
    rev -= floor(rev);
    const float ang = (float)(rev * 6.283185307179586);
    const float2 cs = make_float2(__cosf(ang), __sinf(ang));
    if (e < 32) p.cs64[tok * 32 + e] = cs; else p.cs32[tok * 16 + (e - 32)] = cs;
  }
}

__device__ void phase1a(const Params& p, char* smem) {
  float* sa = (float*)smem; float* ssh = sa + 1024;
  int tid = threadIdx.x; asm volatile("" : "+v"(tid)); const int lane = tid & 63, wave = tid >> 6;
  for (int idx = blockIdx.x * 256 + tid; idx < 4096; idx += gridDim.x * 256) {
    const int b = idx >> 10, n = idx & 1023;
    float v = p.ada_b[2048 + n];
    for (int kc = 0; kc < 16; ++kc) v += p.modp[(kc * 4 + b) * 3072 + 2048 + n];
    p.gatef[idx] = v;
  }
  for (int ch = blockIdx.x; ch < 512; ch += gridDim.x) {
    const int b = (ch * 32) / S_LEN;
    __syncthreads();
    for (int n = tid; n < 1024; n += 256) {
      float sh = p.ada_b[n], sc = p.ada_b[1024 + n];
      for (int kc = 0; kc < 16; ++kc) { sh += p.modp[(kc * 4 + b) * 3072 + n]; sc += p.modp[(kc * 4 + b) * 3072 + 1024 + n]; }
      sa[n] = p.norm_g[n] * (1.f + sc); ssh[n] = sh;
    }
    __syncthreads();
    for (int rr = 0; rr < 8; ++rr) {
      const int row = ch * 32 + wave * 8 + rr;
      const float4* xr = (const float4*)(p.x + (size_t)row * 1024);
      float4 v[4]; float ss = 0.f;
#pragma unroll
      for (int i = 0; i < 4; ++i) { v[i] = ld_nt(xr + i * 64 + lane); ss += v[i].x * v[i].x + v[i].y * v[i].y + v[i].z * v[i].z + v[i].w * v[i].w; }
      ss = wave_sum(ss);
      const float rstd = rsqrtf(ss * (1.f / 1024.f) + 1e-6f);
#pragma unroll
      for (int i = 0; i < 4; ++i) {
        const int col = (i * 64 + lane) * 4;
        const float h0 = v[i].x * rstd * sa[col] + ssh[col], h1 = v[i].y * rstd * sa[col + 1] + ssh[col + 1];
        const float h2 = v[i].z * rstd * sa[col + 2] + ssh[col + 2], h3 = v[i].w * rstd * sa[col + 3] + ssh[col + 3];
        uint2 o; o.x = pack2(h0, h1); o.y = pack2(h2, h3);
        *(uint2*)(p.H + (size_t)row * 1024 + col) = o;
      }
    }
  }
  prep_items<false>(p, smem);
}

DI void store_staged(bf16_t* __restrict__ dst, int ld, f32x4 (&acc)[4][4], int m0, int cb, int lane, bf16_t* stg) {
  const int c = lane & 15, g = lane >> 4;
#pragma unroll
  for (int mi = 0; mi < 4; ++mi)
#pragma unroll
    for (int ni = 0; ni < 4; ++ni)
#pragma unroll
      for (int r = 0; r < 4; ++r) stg[(mi * 16 + g * 4 + r) * 72 + ni * 16 + c] = f2bf(acc[mi][ni][r]);
  asm volatile("s_waitcnt lgkmcnt(0)" ::: "memory");
  const int rr = lane >> 3, cc = (lane & 7) * 8;
#pragma unroll
  for (int i = 0; i < 8; ++i) {
    const uint4 v = *(const uint4*)(stg + (i * 8 + rr) * 72 + cc);
    *(uint4*)(dst + (size_t)(m0 + i * 8 + rr) * ld + cb + cc) = v;
  }
}
DI void store_plain(bf16_t* __restrict__ dst, int ld, f32x4 (&acc)[4][4], int m0, int cb, int lane) {
  const int c = lane & 15, g = lane >> 4;
  bf16_t* base = dst + (size_t)(m0 + g * 4) * ld + cb + c;
#pragma unroll
  for (int mi = 0; mi < 4; ++mi) {
#pragma unroll
    for (int r = 0; r < 4; ++r) {
      bf16_t* rp = base + (size_t)(mi * 16 + r) * ld;
#pragma unroll
      for (int ni = 0; ni < 4; ++ni) rp[ni * 16] = f2bf(acc[mi][ni][r]);
    }
    __builtin_amdgcn_sched_barrier(0);
  }
}
DI void store_T(bf16_t* __restrict__ dstT, int heads_per_b, int hidx, f32x4 (&acc)[4][4], int m0, int lane) {
  const int c = lane & 15, g = lane >> 4;
#pragma unroll
  for (int mi = 0; mi < 4; ++mi) {
    const int tok0 = m0 + mi * 16 + g * 4;
    const int b = tok0 / S_LEN, s0 = tok0 % S_LEN;
#pragma unroll
    for (int ni = 0; ni < 4; ++ni) {
      uint2 o; o.x = pack2(acc[mi][ni][0], acc[mi][ni][1]); o.y = pack2(acc[mi][ni][2], acc[mi][ni][3]);
      *(uint2*)(dstT + ((size_t)(b * heads_per_b + hidx) * 64 + ni * 16 + c) * S_LEN + s0) = o;
    }
  }
}
DI void rope64_acc(const float2* __restrict__ cs64, f32x4 (&acc)[4][4], int m0, int lane) {
  const int c = lane & 15, g = lane >> 4;
#pragma unroll
  for (int mi = 0; mi < 4; ++mi)
#pragma unroll
    for (int r = 0; r < 4; ++r) {
      const int tok = m0 + mi * 16 + g * 4 + r;
#pragma unroll
      for (int h2 = 0; h2 < 2; ++h2) {
        const float2 cs = cs64[tok * 32 + h2 * 16 + c];
        const float x1 = acc[mi][h2][r], x2 = acc[mi][h2 + 2][r];
        acc[mi][h2][r] = x1 * cs.x - x2 * cs.y;
        acc[mi][h2 + 2][r] = x2 * cs.x + x1 * cs.y;
      }
    }
}
DI void rope32_acc(const float2* __restrict__ cs32, f32x4 (&acc)[4][4], int na, int m0, int lane) {
  const int c = lane & 15, g = lane >> 4;
#pragma unroll
  for (int mi = 0; mi < 4; ++mi)
#pragma unroll
    for (int r = 0; r < 4; ++r) {
      const int tok = m0 + mi * 16 + g * 4 + r;
      const float2 cs = cs32[tok * 16 + c];
      const float x1 = acc[mi][na][r], x2 = acc[mi][na + 1][r];
      acc[mi][na][r] = x1 * cs.x - x2 * cs.y;
      acc[mi][na + 1][r] = x2 * cs.x + x1 * cs.y;
    }
}

DI void p1b_epilogue(const Params& p, f32x4 (&acc)[4][4], int m0, int cb, int lane, bf16_t* stg) {
  const int c = lane & 15, g = lane >> 4;
  if (cb >= LDP) return;
  const bool rope64 = (cb < 512) || (cb >= 768 && cb < 896) || (cb >= 1024 && cb < 1152);
  const bool vt = (cb >= 896 && cb < 1024) || (cb >= 1152 && cb < 1280);
  const bool silu = (cb >= PC_ZN && cb < PC_CQ) || (cb >= PC_ZM && cb < PC_KR);
  const bool ssqf = (cb >= PC_CQ && cb < PC_ZM);
  if (rope64) rope64_acc(p.cs64, acc, m0, lane);
  if (silu) {
#pragma unroll
    for (int mi = 0; mi < 4; ++mi)
#pragma unroll
      for (int ni = 0; ni < 4; ++ni)
#pragma unroll
        for (int r = 0; r < 4; ++r) { const float v = acc[mi][ni][r]; acc[mi][ni][r] = v / (1.f + __expf(-v)); }
  }
  if (cb == PC_KR) {
    rope32_acc(p.cs32, acc, 0, m0, lane);
#pragma unroll
    for (int mi = 0; mi < 4; ++mi)
#pragma unroll
      for (int ni = 2; ni < 4; ++ni)
#pragma unroll
        for (int r = 0; r < 4; ++r) { const float v = acc[mi][ni][r]; acc[mi][ni][r] = 1.f / (1.f + __expf(-v)); }
  }
  if (ssqf) {
    const int slot = (cb - PC_CQ) >> 6;
#pragma unroll
    for (int mi = 0; mi < 4; ++mi)
#pragma unroll
      for (int r = 0; r < 4; ++r) {
        float s = 0.f;
#pragma unroll
        for (int ni = 0; ni < 4; ++ni) s += acc[mi][ni][r] * acc[mi][ni][r];
        s += __shfl_xor(s, 8); s += __shfl_xor(s, 4); s += __shfl_xor(s, 2); s += __shfl_xor(s, 1);
        if (c == 0) p.ssq[(size_t)(m0 + mi * 16 + g * 4 + r) * 8 + slot] = s;
      }
  }
  if (vt) {
    bf16_t* dst = (cb < 1024) ? p.VsT : p.VwT;
    const int gk = (cb >> 6) & 1;
    store_T(dst, 2, gk, acc, m0, lane);
  } else {
    store_staged(p.P, LDP, acc, m0, cb, lane, stg);
  }
}

__device__ void phase1b(const Params& p, char* smem) {
  const int xcd = blockIdx.x & 7, lid = blockIdx.x >> 3, nl = (gridDim.x - xcd + 7) >> 3;
  for (int t = lid; t < 176; t += nl) {
    int tid = threadIdx.x; asm volatile("" : "+v"(tid)); const int lane = tid & 63, wave = tid >> 6, wm = wave >> 1, wn = wave & 1;
    int mt, nt;
    if (t < 128) { mt = xcd * 8 + ((t & 63) >> 3); nt = (t >> 6) * 8 + (t & 7); }
    else { const int rem = t - 128; mt = xcd * 8 + rem / 6; nt = 16 + rem % 6; }
    f32x4 accA[4][4], accB[4][4]; zero_acc44(accA); zero_acc44(accB);
    const bf16_t* A = p.H + (size_t)mt * 256 * 1024;
    const bf16_t* B = p.WinT + (size_t)nt * 128 * 1024;
    gemm256(accA, accB, 1024,
            [&](int r, int k) { return *(const uint4*)(A + (size_t)r * 1024 + k); },
            [&](int r, int k) { return *(const uint4*)(B + (size_t)r * 1024 + k); }, (bf16_t*)smem);
    __syncthreads();
    p1b_epilogue(p, accA, mt * 256 + wm * 128, nt * 128 + wn * 64, lane, (bf16_t*)smem + wave * (64 * 72));
    p1b_epilogue(p, accB, mt * 256 + wm * 128 + 64, nt * 128 + wn * 64, lane, (bf16_t*)smem + wave * (64 * 72));
  }
}

DI void scale_rows(const float* __restrict__ ssq, int slot0, int nslot, float invn, f32x4 (&acc)[4][4], int m0, int lane) {
  const int g = lane >> 4;
#pragma unroll
  for (int mi = 0; mi < 4; ++mi) {
#pragma unroll
    for (int r = 0; r < 4; ++r) {
      const int tok = m0 + mi * 16 + g * 4 + r;
      float s;
      if (nslot == 4) { const float4 v = *(const float4*)(ssq + (size_t)tok * 8 + slot0); s = (v.x + v.y) + (v.z + v.w); }
      else { const float2 v = *(const float2*)(ssq + (size_t)tok * 8 + slot0); s = v.x + v.y; }
      const float rstd = rsqrtf(s * invn + 1e-6f);
#pragma unroll
      for (int ni = 0; ni < 4; ++ni) acc[mi][ni][r] *= rstd;
    }
    __builtin_amdgcn_sched_barrier(0);
  }
}

__device__ void compress_finish_item(const Params& p, int which, int b, int gk, int half, char* smem) {
  int tid = threadIdx.x; asm volatile("" : "+v"(tid)); const int lane = tid & 63, wave = tid >> 6;
  const int c = lane & 15, g = lane >> 4;
  const int n0 = half * 128;
  const int bg = b * 2 + gk;
  const bf16_t* W2 = which ? p.W2vT : p.W2kT;
  bf16_t* hid = (bf16_t*)smem;
  const float* part = p.cpart + (size_t)(((which * 8 + bg) * 2 + half) * 8) * 16384;
  __syncthreads();
#pragma unroll 2
  for (int i = 0; i < 16; ++i) {
    const int e4 = tid + 256 * i, row = e4 >> 5, col = (e4 & 31) * 4;
    float4 a = *(const float4*)(part + row * 128 + col);
#pragma unroll
    for (int kc = 1; kc < 8; ++kc) {
      const float4 t = *(const float4*)(part + (size_t)kc * 16384 + row * 128 + col);
      a.x += t.x; a.y += t.y; a.z += t.z; a.w += t.w;
    }
    float4 bb = make_float4(0.f, 0.f, 0.f, 0.f);
#pragma unroll
    for (int kc = 0; kc < 8; ++kc) {
      const float4 t = *(const float4*)(p.cbp + (which * 8 + kc) * 128 + col);
      bb.x += t.x; bb.y += t.y; bb.z += t.z; bb.w += t.w;
    }
    a.x += bb.x; a.y += bb.y; a.z += bb.z; a.w += bb.w;
    uint2 o;
    o.x = pack2(a.x / (1.f + __expf(-a.x)), a.y / (1.f + __expf(-a.y)));
    o.y = pack2(a.z / (1.f + __expf(-a.z)), a.w / (1.f + __expf(-a.w)));
    *(uint2*)(hid + row * 136 + col) = o;
  }
  __syncthreads();
  f32x4 a2[2][4];
#pragma unroll
  for (int mi = 0; mi < 2; ++mi)
#pragma unroll
    for (int ni = 0; ni < 4; ++ni) a2[mi][ni] = f32x4{0.f, 0.f, 0.f, 0.f};
#pragma unroll
  for (int ks = 0; ks < 4; ++ks) {
    bf16x8 af[2], bfr[4];
#pragma unroll
    for (int mi = 0; mi < 2; ++mi) af[mi] = *(const bf16x8*)(hid + (wave * 32 + mi * 16 + c) * 136 + ks * 32 + g * 8);
#pragma unroll
    for (int ni = 0; ni < 4; ++ni) bfr[ni] = *(const bf16x8*)(W2 + (ni * 16 + c) * 128 + ks * 32 + g * 8);
#pragma unroll
    for (int mi = 0; mi < 2; ++mi)
#pragma unroll
      for (int ni = 0; ni < 4; ++ni) a2[mi][ni] = MFMA16(af[mi], bfr[ni], a2[mi][ni]);
  }
  if (which == 0) {
#pragma unroll
    for (int mi = 0; mi < 2; ++mi)
#pragma unroll
      for (int r = 0; r < 4; ++r) {
        const int n = n0 + wave * 32 + mi * 16 + g * 4 + r;
        const bool ok = n < 255;
        const int tok = b * S_LEN + (ok ? 16 * n + 31 : 0);
#pragma unroll
        for (int h2 = 0; h2 < 2; ++h2) {
          const float2 cs = p.cs64[tok * 32 + h2 * 16 + c];
          const float x1 = a2[mi][h2][r], x2 = a2[mi][h2 + 2][r];
          const float o1 = ok ? x1 * cs.x - x2 * cs.y : 0.f, o2 = ok ? x2 * cs.x + x1 * cs.y : 0.f;
          p.KC[((size_t)bg * 256 + n) * 64 + h2 * 16 + c] = f2bf(o1);
          p.KC[((size_t)bg * 256 + n) * 64 + (h2 + 2) * 16 + c] = f2bf(o2);
        }
      }
  } else {
#pragma unroll
    for (int mi = 0; mi < 2; ++mi) {
      const int nb = n0 + wave * 32 + mi * 16 + g * 4;
#pragma unroll
      for (int ni = 0; ni < 4; ++ni) {
        float v[4];
#pragma unroll
        for (int r = 0; r < 4; ++r) v[r] = (nb + r < 255) ? a2[mi][ni][r] : 0.f;
        uint2 o; o.x = pack2(v[0], v[1]); o.y = pack2(v[2], v[3]);
        *(uint2*)(p.VCt + ((size_t)bg * 64 + ni * 16 + c) * 256 + nb) = o;
      }
    }
  }
}
__device__ void phase2b(const Params& p, char* smem) {
  for (int it = blockIdx.x; it < 32; it += gridDim.x)
    compress_finish_item(p, it & 1, (it >> 1) & 3, (it >> 3) & 1, (it >> 4) & 1, smem);
}

__device__ void phase2(const Params& p, char* smem) {
  constexpr int N_CMP = 256, N_Q = 128 * 6, N_KV = 128 * 8;
  int it = blockIdx.x;
  for (; it < N_CMP; it += gridDim.x) {
    int tid = threadIdx.x; asm volatile("" : "+v"(tid)); const int lane = tid & 63, wave = tid >> 6, wm = wave >> 1, wn = wave & 1;
    {
      const int kc = it & 7, item = it >> 3;
      const int half = item & 1, bg = (item >> 1) & 7, which = item >> 4;
      const int b = bg >> 1, gk = bg & 1;
      const bf16_t* src = p.P + (size_t)b * S_LEN * LDP + (which ? PC_VC : PC_KC) + gk * 64;
      const bf16_t* W1 = (which ? p.W1vT : p.W1kT) + kc * 256;
      const int n0 = half * 128;
      f32x4 acc[4][4]; zero_acc44(acc);
      gemm128(acc, 256,
              [&](int r, int k) {
                const int n = n0 + r, kk = kc * 256 + k;
                uint4 o = make_uint4(0u, 0u, 0u, 0u);
                if (n < 255) o = *(const uint4*)(src + (size_t)(16 * n + (kk >> 6)) * LDP + (kk & 63));
                return o;
              },
              [&](int r, int k) { return *(const uint4*)(W1 + (size_t)r * 2048 + k); }, (bf16_t*)smem);
      float* dst = p.cpart + (size_t)it * 16384;
      const int c = lane & 15, g = lane >> 4;
#pragma unroll
      for (int mi = 0; mi < 4; ++mi)
#pragma unroll
        for (int ni = 0; ni < 4; ++ni)
#pragma unroll
          for (int r = 0; r < 4; ++r)
            dst[(wm * 64 + mi * 16 + g * 4 + r) * 128 + wn * 64 + ni * 16 + c] = acc[mi][ni][r];
    }
  }
  for (; it < N_CMP + N_Q; it += gridDim.x) {
    int tid = threadIdx.x; asm volatile("" : "+v"(tid)); const int lane = tid & 63, wave = tid >> 6, wm = wave >> 1, wn = wave & 1;
    {
      const int t = it - N_CMP, mt = t / 6, nt = t % 6;
      f32x4 acc[4][4]; zero_acc44(acc);
      const bf16_t* A = p.P + (size_t)mt * 128 * LDP + PC_CQ;
      const bf16_t* B = p.WqT + (size_t)nt * 128 * 256;
      gemm128(acc, 256,
              [&](int r, int k) { return *(const uint4*)(A + (size_t)r * LDP + k); },
              [&](int r, int k) { return *(const uint4*)(B + (size_t)r * 256 + k); }, (bf16_t*)smem);
      const int m0 = mt * 128 + wm * 64, cb = nt * 128 + wn * 64;
      __syncthreads();
      scale_rows(p.ssq, 0, 4, 1.f / 256.f, acc, m0, lane);
      if (cb >= 512) { rope32_acc(p.cs32, acc, 0, m0, lane); rope32_acc(p.cs32, acc, 2, m0, lane); }
      store_staged(p.Qm, 768, acc, m0, cb, lane, (bf16_t*)smem + wave * (64 * 72));
    }
  }
  for (; it < N_CMP + N_Q + N_KV; it += gridDim.x) {
    int tid = threadIdx.x; asm volatile("" : "+v"(tid)); const int lane = tid & 63, wave = tid >> 6, wm = wave >> 1, wn = wave & 1;
    {
      const int t = it - N_CMP - N_Q, mt = t / 8, nt = t % 8;
      f32x4 acc[4][4]; zero_acc44(acc);
      const bf16_t* A = p.P + (size_t)mt * 128 * LDP + PC_CKV;
      const bf16_t* B = p.WkvT + (size_t)nt * 128 * 128;
      gemm128(acc, 128,
              [&](int r, int k) { return *(const uint4*)(A + (size_t)r * LDP + k); },
              [&](int r, int k) { return *(const uint4*)(B + (size_t)r * 128 + k); }, (bf16_t*)smem);
      const int m0 = mt * 128 + wm * 64, cb = nt * 128 + wn * 64;
      __syncthreads();
      scale_rows(p.ssq, 4, 2, 1.f / 128.f, acc, m0, lane);
      if (cb < 512) store_staged(p.Kn, 512, acc, m0, cb, lane, (bf16_t*)smem + wave * (64 * 72));
      else store_T(p.VmT, 8, (cb - 512) >> 6, acc, m0, lane);
    }
  }
}

typedef __attribute__((ext_vector_type(16))) float f32x16;
#define MFMA32(a, b, c) __builtin_amdgcn_mfma_f32_32x32x16_bf16((a), (b), (c), 0, 0, 0)
constexpr float MASKV = -1e32f;

DI void zero16x2(f32x16 (&a)[2]) {
#pragma unroll
  for (int i = 0; i < 2; ++i)
#pragma unroll
    for (int j = 0; j < 16; ++j) a[i][j] = 0.f;
}
template <int KS>
DI void score32(const bf16x8 (&qf)[KS], const bf16_t* sK, int ldk, f32x16 (&s)[2], int lane) {
  const int r = lane & 31, h = lane >> 5;
#pragma unroll
  for (int kt = 0; kt < 2; ++kt) {
#pragma unroll
    for (int j = 0; j < 16; ++j) s[kt][j] = 0.f;
#pragma unroll
    for (int ks = 0; ks < KS; ++ks) {
      const bf16x8 kf = *(const bf16x8*)(sK + (kt * 32 + r) * ldk + ks * 16 + 8 * h);
      s[kt] = MFMA32(kf, qf[ks], s[kt]);
    }
  }
}
template <int KS>
DI void score32x(const bf16x8 (&qf)[KS], const bf16_t* sK, int ldk, f32x16 (&s)[2], int lane) {
  const int r = lane & 31, h = lane >> 5;
  bf16x8 kf[2][KS];
#pragma unroll
  for (int kt = 0; kt < 2; ++kt)
#pragma unroll
    for (int ks = 0; ks < KS; ++ks) kf[kt][ks] = *(const bf16x8*)(sK + (kt * 32 + r) * ldk + ks * 16 + 8 * h);
  __builtin_amdgcn_sched_barrier(0);
#pragma unroll
  for (int kt = 0; kt < 2; ++kt)
#pragma unroll
    for (int j = 0; j < 16; ++j) s[kt][j] = 0.f;
#pragma unroll
  for (int ks = 0; ks < KS; ++ks)
#pragma unroll
    for (int kt = 0; kt < 2; ++kt) s[kt] = MFMA32(kf[kt][ks], qf[ks], s[kt]);
}
DI void pv32(const f32x16 (&pr)[2], const bf16_t* sVt, f32x16 (&o)[2], int lane) {
  const int r = lane & 31, h = lane >> 5;
#pragma unroll
  for (int kt = 0; kt < 2; ++kt)
#pragma unroll
    for (int st = 0; st < 2; ++st) {
      uint4 u;
      u.x = pack2(pr[kt][8 * st + 0], pr[kt][8 * st + 1]); u.y = pack2(pr[kt][8 * st + 2], pr[kt][8 * st + 3]);
      u.z = pack2(pr[kt][8 * st + 4], pr[kt][8 * st + 5]); u.w = pack2(pr[kt][8 * st + 6], pr[kt][8 * st + 7]);
      const bf16x8 pb = __builtin_bit_cast(bf16x8, u);
#pragma unroll
      for (int dt = 0; dt < 2; ++dt) {
        const bf16_t* vp = sVt + (dt * 32 + r) * LDV + kt * 32 + 16 * st + 4 * (h ^ ((r >> 4) & 1));
        const uint2 lo = *(const uint2*)vp;
        const uint2 hi = *(const uint2*)(vp + 8);
        const uint4 v4 = make_uint4(lo.x, lo.y, hi.x, hi.y);
        o[dt] = MFMA32(__builtin_bit_cast(bf16x8, v4), pb, o[dt]);
      }
    }
}
template <int MODE, bool PV, class VF>
DI void softmax32(f32x16 (&s)[2], float& m, float& l, f32x16 (&o)[2], float sl2, bool lanesel, VF valid) {
  float mx0 = MASKV, mx1 = MASKV, mx2 = MASKV, mx3 = MASKV;
#pragma unroll
  for (int kt = 0; kt < 2; ++kt)
#pragma unroll
    for (int q4 = 0; q4 < 4; ++q4) {
      if (MODE == 2) {
#pragma unroll
        for (int i = 0; i < 4; ++i) s[kt][q4 * 4 + i] = valid(kt, q4 * 4 + i) ? s[kt][q4 * 4 + i] : MASKV;
      }
      mx0 = fmaxf(mx0, s[kt][q4 * 4 + 0]); mx1 = fmaxf(mx1, s[kt][q4 * 4 + 1]);
      mx2 = fmaxf(mx2, s[kt][q4 * 4 + 2]); mx3 = fmaxf(mx3, s[kt][q4 * 4 + 3]);
    }
  float mx = fmaxf(fmaxf(mx0, mx1), fmaxf(mx2, mx3));
  if (MODE == 1) mx = lanesel ? mx : MASKV;
  mx = fmaxf(mx, __shfl_xor(mx, 32));
  const float mnew = fmaxf(m, mx * sl2);
  const float alpha = __builtin_amdgcn_exp2f(m - mnew);
  m = mnew;
  const float moff = (MODE == 1 && !lanesel) ? 1e30f : mnew;
  float r0 = 0.f, r1 = 0.f, r2 = 0.f, r3 = 0.f;
#pragma unroll
  for (int kt = 0; kt < 2; ++kt)
#pragma unroll
    for (int q4 = 0; q4 < 4; ++q4) {
      const float p0 = __builtin_amdgcn_exp2f(fmaf(s[kt][q4 * 4 + 0], sl2, -moff));
      const float p1 = __builtin_amdgcn_exp2f(fmaf(s[kt][q4 * 4 + 1], sl2, -moff));
      const float p2 = __builtin_amdgcn_exp2f(fmaf(s[kt][q4 * 4 + 2], sl2, -moff));
      const float p3 = __builtin_amdgcn_exp2f(fmaf(s[kt][q4 * 4 + 3], sl2, -moff));
      s[kt][q4 * 4 + 0] = p0; s[kt][q4 * 4 + 1] = p1; s[kt][q4 * 4 + 2] = p2; s[kt][q4 * 4 + 3] = p3;
      r0 += p0; r1 += p1; r2 += p2; r3 += p3;
    }
  l = l * alpha + ((r0 + r1) + (r2 + r3));
  if (PV) {
    if (__any(alpha != 1.f)) {
#pragma unroll
      for (int dt = 0; dt < 2; ++dt)
#pragma unroll
        for (int j = 0; j < 16; ++j) o[dt][j] *= alpha;
    }
  }
}
template <int MODE, class VF>
DI void softmax32_pk(f32x16 (&s)[2], float& m, float& l, f32x16 (&o)[2], float sl2, bool lanesel, VF valid, uint4 (&pk)[2][2]) {
  float mx0 = MASKV, mx1 = MASKV, mx2 = MASKV, mx3 = MASKV;
  float v[2][16];
#pragma unroll
  for (int kt = 0; kt < 2; ++kt)
#pragma unroll
    for (int j = 0; j < 16; ++j) v[kt][j] = (MODE == 2) ? (valid(kt, j) ? s[kt][j] : MASKV) : s[kt][j];
#pragma unroll
  for (int kt = 0; kt < 2; ++kt)
#pragma unroll
    for (int q4 = 0; q4 < 4; ++q4) {
      mx0 = fmaxf(mx0, v[kt][q4 * 4 + 0]); mx1 = fmaxf(mx1, v[kt][q4 * 4 + 1]);
      mx2 = fmaxf(mx2, v[kt][q4 * 4 + 2]); mx3 = fmaxf(mx3, v[kt][q4 * 4 + 3]);
    }
  float mx = fmaxf(fmaxf(mx0, mx1), fmaxf(mx2, mx3));
  if (MODE == 1) mx = lanesel ? mx : MASKV;
  {
    const auto sw = __builtin_amdgcn_permlane32_swap(__float_as_uint(mx), __float_as_uint(mx), false, false);
    mx = fmaxf(__uint_as_float(sw[0]), __uint_as_float(sw[1]));
  }
  constexpr float RESCALE_THR = 8.f;
  const float mxs = mx * sl2;
  float alpha = 1.f;
  if (__any(mxs > m + RESCALE_THR)) {
    asm volatile("" ::: "memory");
    const float mnew = fmaxf(m, mxs);
    alpha = __builtin_amdgcn_exp2f(m - mnew);
    m = mnew;
#pragma unroll
    for (int dt = 0; dt < 2; ++dt)
#pragma unroll
      for (int j = 0; j < 16; ++j) o[dt][j] *= alpha;
  }
  const float moff = (MODE == 1 && !lanesel) ? 1e30f : m;
  float r0 = 0.f, r1 = 0.f, r2 = 0.f, r3 = 0.f;
#pragma unroll
  for (int kt = 0; kt < 2; ++kt)
#pragma unroll
    for (int st = 0; st < 2; ++st) {
      const float p0 = __builtin_amdgcn_exp2f(fmaf(v[kt][8 * st + 0], sl2, -moff));
      const float p1 = __builtin_amdgcn_exp2f(fmaf(v[kt][8 * st + 1], sl2, -moff));
      const float p2 = __builtin_amdgcn_exp2f(fmaf(v[kt][8 * st + 2], sl2, -moff));
      const float p3 = __builtin_amdgcn_exp2f(fmaf(v[kt][8 * st + 3], sl2, -moff));
      const float p4 = __builtin_amdgcn_exp2f(fmaf(v[kt][8 * st + 4], sl2, -moff));
      const float p5 = __builtin_amdgcn_exp2f(fmaf(v[kt][8 * st + 5], sl2, -moff));
      const float p6 = __builtin_amdgcn_exp2f(fmaf(v[kt][8 * st + 6], sl2, -moff));
      const float p7 = __builtin_amdgcn_exp2f(fmaf(v[kt][8 * st + 7], sl2, -moff));
      r0 += p0 + p4; r1 += p1 + p5; r2 += p2 + p6; r3 += p3 + p7;
      pk[kt][st].x = pack2(p0, p1); pk[kt][st].y = pack2(p2, p3); pk[kt][st].z = pack2(p4, p5); pk[kt][st].w = pack2(p6, p7);
    }
  l = l * alpha + ((r0 + r1) + (r2 + r3));
}
DI void pv32_pk(const uint4 (&pk)[2][2], const bf16_t* sVt, f32x16 (&o)[2], int lane) {
  const int r = lane & 31, h = lane >> 5;
#pragma unroll
  for (int kt = 0; kt < 2; ++kt)
#pragma unroll
    for (int st = 0; st < 2; ++st) {
      const bf16x8 pb = __builtin_bit_cast(bf16x8, pk[kt][st]);
#pragma unroll
      for (int dt = 0; dt < 2; ++dt) {
        const bf16_t* vp = sVt + (dt * 32 + r) * LDV + kt * 32 + 16 * st + 4 * (h ^ ((r >> 4) & 1));
        const uint2 lo = *(const uint2*)vp;
        const uint2 hi = *(const uint2*)(vp + 8);
        const uint4 v4 = make_uint4(lo.x, lo.y, hi.x, hi.y);
        o[dt] = MFMA32(__builtin_bit_cast(bf16x8, v4), pb, o[dt]);
      }
    }
}
DI void load_vfrag(bf16x8 (&vf)[2][2], const bf16_t* sVt, int kt, int lane) {
  const int r = lane & 31, h = lane >> 5;
#pragma unroll
  for (int st = 0; st < 2; ++st)
#pragma unroll
    for (int dt = 0; dt < 2; ++dt) {
      const bf16_t* vp = sVt + (dt * 32 + r) * LDV + kt * 32 + 16 * st + 4 * (h ^ ((r >> 4) & 1));
      const uint2 lo = *(const uint2*)vp;
      const uint2 hi = *(const uint2*)(vp + 8);
      const uint4 v4 = make_uint4(lo.x, lo.y, hi.x, hi.y);
      vf[st][dt] = __builtin_bit_cast(bf16x8, v4);
    }
}
template <int MODE, class VF>
DI void softmax_pv32(f32x16 (&s)[2], float& m, float& l, f32x16 (&o)[2], float sl2, bool lanesel, VF valid, const bf16_t* sVt, int lane) {
  bf16x8 vf[2][2];
  load_vfrag(vf, sVt, 0, lane);
  float mx0 = MASKV, mx1 = MASKV, mx2 = MASKV, mx3 = MASKV;
  float v[2][16];
#pragma unroll
  for (int kt = 0; kt < 2; ++kt)
#pragma unroll
    for (int j = 0; j < 16; ++j) v[kt][j] = (MODE == 2) ? (valid(kt, j) ? s[kt][j] : MASKV) : s[kt][j];
#pragma unroll
  for (int kt = 0; kt < 2; ++kt)
#pragma unroll
    for (int q4 = 0; q4 < 4; ++q4) {
      mx0 = fmaxf(mx0, v[kt][q4 * 4 + 0]); mx1 = fmaxf(mx1, v[kt][q4 * 4 + 1]);
      mx2 = fmaxf(mx2, v[kt][q4 * 4 + 2]); mx3 = fmaxf(mx3, v[kt][q4 * 4 + 3]);
    }
  float mx = fmaxf(fmaxf(mx0, mx1), fmaxf(mx2, mx3));
  if (MODE == 1) mx = lanesel ? mx : MASKV;
  {
    const auto sw = __builtin_amdgcn_permlane32_swap(__float_as_uint(mx), __float_as_uint(mx), false, false);
    mx = fmaxf(__uint_as_float(sw[0]), __uint_as_float(sw[1]));
  }
  constexpr float RESCALE_THR = 8.f;
  const float mxs = mx * sl2;
  float alpha = 1.f;
  if (__any(mxs > m + RESCALE_THR)) {
    asm volatile("" ::: "memory");
    const float mnew = fmaxf(m, mxs);
    alpha = __builtin_amdgcn_exp2f(m - mnew);
    m = mnew;
#pragma unroll
    for (int dt = 0; dt < 2; ++dt)
#pragma unroll
      for (int j = 0; j < 16; ++j) o[dt][j] *= alpha;
  }
  const float moff = (MODE == 1 && !lanesel) ? 1e30f : m;
  float r0 = 0.f, r1 = 0.f, r2 = 0.f, r3 = 0.f;
  uint4 pk0[2], pk1[2];
  bf16x8 vf1[2][2];
#define SM_HALF(KT, PK) _Pragma("unroll") for (int st = 0; st < 2; ++st) { \
      const float p0 = __builtin_amdgcn_exp2f(fmaf(v[KT][8 * st + 0], sl2, -moff)); \
      const float p1 = __builtin_amdgcn_exp2f(fmaf(v[KT][8 * st + 1], sl2, -moff)); \
      const float p2 = __builtin_amdgcn_exp2f(fmaf(v[KT][8 * st + 2], sl2, -moff)); \
      const float p3 = __builtin_amdgcn_exp2f(fmaf(v[KT][8 * st + 3], sl2, -moff)); \
      const float p4 = __builtin_amdgcn_exp2f(fmaf(v[KT][8 * st + 4], sl2, -moff)); \
      const float p5 = __builtin_amdgcn_exp2f(fmaf(v[KT][8 * st + 5], sl2, -moff)); \
      const float p6 = __builtin_amdgcn_exp2f(fmaf(v[KT][8 * st + 6], sl2, -moff)); \
      const float p7 = __builtin_amdgcn_exp2f(fmaf(v[KT][8 * st + 7], sl2, -moff)); \
      r0 += p0 + p4; r1 += p1 + p5; r2 += p2 + p6; r3 += p3 + p7; \
      PK[st].x = pack2(p0, p1); PK[st].y = pack2(p2, p3); PK[st].z = pack2(p4, p5); PK[st].w = pack2(p6, p7); }
  SM_HALF(0, pk0)
  __builtin_amdgcn_sched_barrier(0);
  load_vfrag(vf1, sVt, 1, lane);
#pragma unroll
  for (int st = 0; st < 2; ++st)
#pragma unroll
    for (int dt = 0; dt < 2; ++dt) o[dt] = MFMA32(vf[st][dt], __builtin_bit_cast(bf16x8, pk0[st]), o[dt]);
  SM_HALF(1, pk1)
  __builtin_amdgcn_sched_group_barrier(0x100, 4, 0);
#pragma unroll
  for (int q = 0; q < 4; ++q) {
    __builtin_amdgcn_sched_group_barrier(0x008, 1, 0);
    __builtin_amdgcn_sched_group_barrier(0x002, 14, 0);
  }
  __builtin_amdgcn_sched_barrier(0);
#pragma unroll
  for (int st = 0; st < 2; ++st)
#pragma unroll
    for (int dt = 0; dt < 2; ++dt) o[dt] = MFMA32(vf1[st][dt], __builtin_bit_cast(bf16x8, pk1[st]), o[dt]);
#undef SM_HALF
  l = l * alpha + ((r0 + r1) + (r2 + r3));
}
DI float half_sum(float v) { return v + __shfl_xor(v, 32); }
DI int crow32(int reg, int h) { return (reg & 3) + 8 * (reg >> 2) + 4 * h; }

#define ISSUE_K(gK_, ldk_) { const bf16_t* gp_ = (gK_) + (size_t)lrow * (ldk_) + lcc; rk0 = *(const uint4*)gp_; rk1 = *(const uint4*)(gp_ + (size_t)32 * (ldk_)); }
#define ISSUE_V(gV_, ldv_) { const bf16_t* gp_ = (gV_) + (size_t)lrow * (ldv_) + lcc; rv0 = *(const uint4*)gp_; rv1 = *(const uint4*)(gp_ + (size_t)32 * (ldv_)); }
#define STORE_K(sK_, ldks_) { *(uint4*)((sK_) + lrow * (ldks_) + lcc) = rk0; *(uint4*)((sK_) + (lrow + 32) * (ldks_) + lcc) = rk1; }
#define STORE_V(sV_) { const bool sw_ = (lrow >> 4) & 1; \
    *(uint4*)((sV_) + lrow * LDV + lcc) = sw_ ? make_uint4(rv0.z, rv0.w, rv0.x, rv0.y) : rv0; \
    *(uint4*)((sV_) + (lrow + 32) * LDV + lcc) = sw_ ? make_uint4(rv1.z, rv1.w, rv1.x, rv1.y) : rv1; }

constexpr int LDK64 = 72;

__device__ void nsa_item(const Params& p, int b, int gk, int qt, char* smem) {
  bf16_t* sK = (bf16_t*)smem;
  bf16_t* sVt = sK + 64 * LDK;
  float* imp = (float*)(sVt + 64 * LDV);
  u64* selm = (u64*)(imp + 32 * 65);
  int tid = threadIdx.x; asm volatile("" : "+v"(tid));
  const int lane = tid & 63, wave = tid >> 6;
  const int r = lane & 31, h = lane >> 5;
  const int head = gk * 4 + wave;
  float* stash = (float*)(smem + 31104) + wave * 32 * 64 + lane;
  const int s0 = qt * 32;
  const size_t tok0 = (size_t)b * S_LEN + s0;
  const int bg = b * 2 + gk;
  const float sl2 = 0.125f * 1.4426950408889634f;
  const int sq = s0 + r;
  const bf16_t* qrow = p.P + (tok0 + r) * LDP;
  bf16x8 qf[4];
#pragma unroll
  for (int ks = 0; ks < 4; ++ks) qf[ks] = *(const bf16x8*)(qrow + head * 64 + ks * 16 + 8 * h);
  const float gate0 = bf2f(qrow[PC_GL + head * 3 + 0]);
  const float gate1 = bf2f(qrow[PC_GL + head * 3 + 1]);
  const float gate2 = bf2f(qrow[PC_GL + head * 3 + 2]);
  f32x16 o[2], s[2];
  float m, l;
  uint4 rk0, rk1, rv0, rv1;
  const int lrow = tid >> 3, lcc = (tid & 7) * 8;
  auto novalid = [](int, int) { return true; };

  __syncthreads();
  for (int i = tid; i < 32 * 65; i += 256) imp[i] = 0.f;
  const int nkt = min(3, (s0 >> 4) >> 6) + 1;
  const bf16_t* gKC = p.KC + (size_t)bg * 256 * 64;
  const bf16_t* gVC = p.VCt + (size_t)bg * 64 * 256;
  m = NEGF; l = 0.f;
  zero16x2(o);
  for (int kb = 0; kb < nkt; ++kb) {
    __syncthreads();
    ISSUE_K(gKC + (size_t)kb * 64 * 64, 64);
    STORE_K(sK, LDK64);
    __syncthreads();
    score32<4>(qf, sK, LDK64, s, lane);
    softmax32<2, false>(s, m, l, o, sl2, true, [&](int kt, int reg) {
      return 16 * (kb * 64 + kt * 32 + crow32(reg, h)) + 31 <= sq; });
  }
  {
    const float lt = half_sum(l);
    const float linv = lt > 0.f ? 1.f / lt : 0.f;
    for (int kb = 0; kb < nkt; ++kb) {
      __syncthreads();
      ISSUE_K(gKC + (size_t)kb * 64 * 64, 64);
      ISSUE_V(gVC + kb * 64, 256);
      STORE_K(sK, LDK64);
      STORE_V(sVt);
      __syncthreads();
      score32<4>(qf, sK, LDK64, s, lane);
#pragma unroll
      for (int kt = 0; kt < 2; ++kt)
#pragma unroll
        for (int reg = 0; reg < 16; ++reg) {
          const bool ok = 16 * (kb * 64 + kt * 32 + crow32(reg, h)) + 31 <= sq;
          s[kt][reg] = ok ? __builtin_amdgcn_exp2f(fmaf(s[kt][reg], sl2, -m)) * linv : 0.f;
        }
      for (int w = 0; w < 4; ++w) {
        if (wave == w) {
#pragma unroll
          for (int kt = 0; kt < 2; ++kt)
#pragma unroll
            for (int q4 = 0; q4 < 4; ++q4) {
              float* ip = imp + r * 65 + kb * 16 + kt * 8 + 2 * q4 + h;
              ip[0] += s[kt][q4 * 4 + 0] + s[kt][q4 * 4 + 1] + s[kt][q4 * 4 + 2] + 0.5f * s[kt][q4 * 4 + 3];
            }
          asm volatile("s_waitcnt lgkmcnt(0)" ::: "memory");
#pragma unroll
          for (int kt = 0; kt < 2; ++kt)
#pragma unroll
            for (int q4 = 0; q4 < 4; ++q4) {
              float* ip = imp + r * 65 + kb * 16 + kt * 8 + 2 * q4 + h + 1;
              ip[0] += 0.5f * s[kt][q4 * 4 + 3];
            }
        }
        __syncthreads();
      }
      pv32(s, sVt, o, lane);
    }
  }
#pragma unroll
  for (int dt = 0; dt < 2; ++dt)
#pragma unroll
    for (int j = 0; j < 16; ++j) stash[(dt * 16 + j) * 64] = gate0 * o[dt][j];

  __syncthreads();
#pragma unroll 1
  for (int i = 0; i < 8; ++i) {
    const int ti = wave * 8 + i;
    const int curt = (s0 + ti) >> 6;
    const int j = lane;
    float v = imp[ti * 65 + j];
    if (j == 0 || j == curt || j == curt - 1) v = 1.0e4f; else if (j > curt) v = -1.0e4f;
    int rank = 0;
#pragma unroll 4
    for (int jp = 0; jp <= curt; ++jp) {
      const float vj = __uint_as_float(__builtin_amdgcn_readlane(__float_as_uint(v), jp));
      rank += ((vj > v) || (vj == v && jp < j)) ? 1 : 0;
    }
    if (j > curt) rank = j;
    const u64 mask = __ballot(rank < 16);
    if (lane == 0) selm[ti] = mask;
  }
  __syncthreads();
  const u64 mysel = selm[r];
  const int cur = s0 >> 6;

  {
    m = NEGF; l = 0.f; zero16x2(o);
    const bf16_t* gK = p.P + (size_t)b * S_LEN * LDP + PC_KS + gk * 64;
    const bf16_t* gV = p.VsT + (size_t)bg * 64 * S_LEN;
    ISSUE_K(gK, LDP); ISSUE_V(gV, S_LEN);
    for (int j = 0; j <= cur; ++j) {
      __syncthreads();
      STORE_K(sK, LDK64); STORE_V(sVt);
      __syncthreads();
      if (j < cur) { ISSUE_K(gK + (size_t)(j + 1) * 64 * LDP, LDP); ISSUE_V(gV + (j + 1) * 64, S_LEN); }
      score32x<4>(qf, sK, LDK64, s, lane);
      const bool sel = (mysel >> j) & 1ull;
      if (j < cur) softmax_pv32<1>(s, m, l, o, sl2, sel, novalid, sVt, lane);
      else softmax_pv32<2>(s, m, l, o, sl2, true, [&](int kt, int reg) {
        return sel && (j * 64 + kt * 32 + crow32(reg, h) <= sq); }, sVt, lane);
    }
    const float lt = half_sum(l); const float f = (lt > 0.f ? 1.f / lt : 0.f) * gate1;
#pragma unroll
    for (int dt = 0; dt < 2; ++dt)
#pragma unroll
      for (int j = 0; j < 16; ++j) stash[(dt * 16 + j) * 64] += f * o[dt][j];
  }
  {
    m = NEGF; l = 0.f; zero16x2(o);
    const bf16_t* gK = p.P + (size_t)b * S_LEN * LDP + PC_KW + gk * 64;
    const bf16_t* gV = p.VwT + (size_t)bg * 64 * S_LEN;
    const int jlo = max(0, s0 - 511) >> 6;
    ISSUE_K(gK + (size_t)jlo * 64 * LDP, LDP); ISSUE_V(gV + jlo * 64, S_LEN);
    for (int j = jlo; j <= cur; ++j) {
      __syncthreads();
      STORE_K(sK, LDK64); STORE_V(sVt);
      __syncthreads();
      if (j < cur) { ISSUE_K(gK + (size_t)(j + 1) * 64 * LDP, LDP); ISSUE_V(gV + (j + 1) * 64, S_LEN); }
      score32x<4>(qf, sK, LDK64, s, lane);
      const bool interior = (j * 64 + 63 <= s0) && (j * 64 > s0 + 31 - 512);
      if (interior) softmax_pv32<0>(s, m, l, o, sl2, true, novalid, sVt, lane);
      else softmax_pv32<2>(s, m, l, o, sl2, true, [&](int kt, int reg) {
        const int key = j * 64 + kt * 32 + crow32(reg, h);
        return (key <= sq) && (key > sq - 512); }, sVt, lane);
    }
    const float lt = half_sum(l); const float f = (lt > 0.f ? 1.f / lt : 0.f) * gate2;
#pragma unroll
    for (int dt = 0; dt < 2; ++dt)
#pragma unroll
      for (int j = 0; j < 16; ++j) o[dt][j] = stash[(dt * 16 + j) * 64] + f * o[dt][j];
  }
  {
    const size_t tok = tok0 + r;
#pragma unroll
    for (int dt = 0; dt < 2; ++dt)
#pragma unroll
      for (int q4 = 0; q4 < 4; ++q4) {
        const int dcol = dt * 32 + 8 * q4 + 4 * h;
        const uint2 z = *(const uint2*)(p.P + tok * LDP + PC_ZN + head * 64 + dcol);
        uint2 ov;
        ov.x = pack2(o[dt][q4 * 4 + 0] * __uint_as_float(z.x << 16), o[dt][q4 * 4 + 1] * __uint_as_float(z.x & 0xffff0000u));
        ov.y = pack2(o[dt][q4 * 4 + 2] * __uint_as_float(z.y << 16), o[dt][q4 * 4 + 3] * __uint_as_float(z.y & 0xffff0000u));
        *(uint2*)(p.MIX + tok * 1024 + head * 64 + dcol) = ov;
      }
  }
}

__device__ void mla_item(const Params& p, int b, int hd, int qt, char* smem) {
  bf16_t* sK = (bf16_t*)smem;
  bf16_t* sVt = sK + 64 * LDK;
  int tid = threadIdx.x; asm volatile("" : "+v"(tid));
  const int lane = tid & 63, wave = tid >> 6;
  const int r = lane & 31, h = lane >> 5;
  const int q0 = qt * 128, sw = q0 + wave * 32;
  const size_t tokw = (size_t)b * S_LEN + sw;
  const float sl2 = 0.10206207261596577f * 1.4426950408889634f;
  const int sq = sw + r;
  bf16x8 qf[6];
  {
    const bf16_t* qrow = p.Qm + (tokw + r) * 768;
#pragma unroll
    for (int ks = 0; ks < 4; ++ks) qf[ks] = *(const bf16x8*)(qrow + hd * 64 + ks * 16 + 8 * h);
#pragma unroll
    for (int ks = 0; ks < 2; ++ks) qf[4 + ks] = *(const bf16x8*)(qrow + 512 + hd * 32 + ks * 16 + 8 * h);
  }
  f32x16 o[2], s[2];
  zero16x2(o);
  float m = NEGF, l = 0.f;
  const bf16_t* gKn = p.Kn + (size_t)b * S_LEN * 512 + hd * 64;
  const bf16_t* gKr = p.P + (size_t)b * S_LEN * LDP + PC_KR;
  const bf16_t* gV = p.VmT + (size_t)(b * 8 + hd) * 64 * S_LEN;
  const int nkt = 2 * qt + 2;
  const int kr_r = tid >> 2, kr_c = (tid & 3) * 8;
  uint4 rk0, rk1, rv0, rv1, rkr;
  const int lrow = tid >> 3, lcc = (tid & 7) * 8;
  auto novalid = [](int, int) { return true; };
  ISSUE_K(gKn, 512); ISSUE_V(gV, S_LEN);
  rkr = *(const uint4*)(gKr + (size_t)kr_r * LDP + kr_c);
  for (int kb = 0; kb < nkt; ++kb) {
    __syncthreads();
    STORE_K(sK, LDK); STORE_V(sVt);
    *(uint4*)(sK + kr_r * LDK + 64 + kr_c) = rkr;
    __syncthreads();
    if (kb + 1 < nkt) {
      ISSUE_K(gKn + (size_t)(kb + 1) * 64 * 512, 512); ISSUE_V(gV + (kb + 1) * 64, S_LEN);
      rkr = *(const uint4*)(gKr + (size_t)((kb + 1) * 64 + kr_r) * LDP + kr_c);
    }
    if (kb * 64 <= sw + 31) {
      score32x<6>(qf, sK, LDK, s, lane);
      if (kb * 64 + 63 <= sw) softmax_pv32<0>(s, m, l, o, sl2, true, novalid, sVt, lane);
      else softmax_pv32<2>(s, m, l, o, sl2, true, [&](int kt, int reg) {
        return kb * 64 + kt * 32 + crow32(reg, h) <= sq; }, sVt, lane);
    }
  }
  {
    const float lt = half_sum(l); const float f = lt > 0.f ? 1.f / lt : 0.f;
    const size_t tok = tokw + r;
#pragma unroll
    for (int dt = 0; dt < 2; ++dt)
#pragma unroll
      for (int q4 = 0; q4 < 4; ++q4) {
        const int dcol = dt * 32 + 8 * q4 + 4 * h;
        const uint2 z = *(const uint2*)(p.P + tok * LDP + PC_ZM + hd * 64 + dcol);
        uint2 ov;
        ov.x = pack2(o[dt][q4 * 4 + 0] * f * __uint_as_float(z.x << 16), o[dt][q4 * 4 + 1] * f * __uint_as_float(z.x & 0xffff0000u));
        ov.y = pack2(o[dt][q4 * 4 + 2] * f * __uint_as_float(z.y << 16), o[dt][q4 * 4 + 3] * f * __uint_as_float(z.y & 0xffff0000u));
        *(uint2*)(p.MIX + tok * 1024 + 512 + hd * 64 + dcol) = ov;
      }
  }
}

#define XB_QUEUE(j) (3456 + 2 * 4096 + 64 * (j))
#define XB_KCDONE (3456 + 2 * 4096 + 64 * 8)
__device__ void phase3(const Params& p, char* smem) {
  volatile unsigned* slot = (volatile unsigned*)(smem + SMEM_BYTES - 16);
  for (int it = blockIdx.x; it < 32; it += gridDim.x) {
    compress_finish_item(p, it & 1, (it >> 1) & 3, (it >> 3) & 1, (it >> 4) & 1, smem);
    asm volatile("s_waitcnt vmcnt(0)" ::: "memory");
    __syncthreads();
    if (threadIdx.x == 0) {
      __builtin_amdgcn_fence(__ATOMIC_RELEASE, "agent");
      asm volatile("s_waitcnt vmcnt(0)" ::: "memory");
      __hip_atomic_fetch_add(p.bar + XB_KCDONE, 1u, __ATOMIC_RELAXED, __HIP_MEMORY_SCOPE_AGENT);
    }
  }
  bool kc_ready = false;
  const unsigned myx = (unsigned)__builtin_amdgcn_s_getreg((3 << 11) | 20) & 7u;
#pragma unroll 1
  for (unsigned k = 0; k < 8; ++k) {
    const unsigned xq = (myx + k) & 7u;
#pragma unroll 1
    for (;;) {
      __syncthreads();
      if (threadIdx.x == 0) *slot = __hip_atomic_fetch_add(p.bar + XB_QUEUE(xq), 1u, __ATOMIC_RELAXED, __HIP_MEMORY_SCOPE_AGENT);
      __syncthreads();
      const unsigned q = *slot;
      if (q >= 256u) break;
      const unsigned code = p.order[q];
      if (code & 128u) {
        if (!kc_ready) {
          if (threadIdx.x == 0) {
            unsigned spins = 0;
            while (__hip_atomic_load(p.bar + XB_KCDONE, __ATOMIC_RELAXED, __HIP_MEMORY_SCOPE_AGENT) < 32u) {
              __builtin_amdgcn_s_sleep(2);
              if (++spins > (1u << 22)) break;
            }
            __builtin_amdgcn_fence(__ATOMIC_ACQUIRE, "agent");
            asm volatile("s_waitcnt vmcnt(0)" ::: "memory");
          }
          __syncthreads();
          kc_ready = true;
        }
        nsa_item(p, xq & 3, xq >> 2, code & 127u, smem);
      } else { const int pid = xq + 8 * ((code >> 5) & 3); mla_item(p, pid & 3, pid >> 2, code & 31u, smem); }
    }
  }
}

DI void p4_epilogue(const Params& p, f32x4 (&acc)[4][4], int m0, int cb, int lane, float* stg) {
  const int c = lane & 15, g = lane >> 4;
  const int b = m0 / S_LEN;
  const int rl = lane >> 4, col = (lane & 15) * 4;
  const float4 gt = *(const float4*)(p.gatef + b * 1024 + cb + col);
#pragma unroll
  for (int hf = 0; hf < 2; ++hf) {
#pragma unroll
    for (int mi2 = 0; mi2 < 2; ++mi2)
#pragma unroll
      for (int ni = 0; ni < 4; ++ni)
#pragma unroll
        for (int r = 0; r < 4; ++r) stg[(mi2 * 16 + g * 4 + r) * 68 + ni * 16 + c] = acc[hf * 2 + mi2][ni][r];
    asm volatile("s_waitcnt lgkmcnt(0)" ::: "memory");
#pragma unroll
    for (int i = 0; i < 8; ++i) {
      const float4 a = *(const float4*)(stg + (i * 4 + rl) * 68 + col);
      const size_t off = (size_t)(m0 + hf * 32 + i * 4 + rl) * 1024 + cb + col;
      const float4 xv = ld_nt((const float4*)(p.x + off));
      float4 o; o.x = xv.x + gt.x * a.x; o.y = xv.y + gt.y * a.y; o.z = xv.z + gt.z * a.z; o.w = xv.w + gt.w * a.w;
      *(float4*)(p.out + off) = o;
    }
    asm volatile("s_waitcnt lgkmcnt(0)" ::: "memory");
  }
}
__device__ void phase4(const Params& p, char* smem) {
  const int xcd = blockIdx.x & 7, lid = blockIdx.x >> 3, nl = (gridDim.x - xcd + 7) >> 3;
  for (int t = lid; t < 64; t += nl) {
    int tid = threadIdx.x; asm volatile("" : "+v"(tid)); const int lane = tid & 63, wave = tid >> 6, wm = wave >> 1, wn = wave & 1;
    const int mt = xcd * 8 + (t >> 3), nt = t & 7;
    f32x4 accA[4][4], accB[4][4]; zero_acc44(accA); zero_acc44(accB);
    const bf16_t* A = p.MIX + (size_t)mt * 256 * 1024;
    const bf16_t* B = p.WoutT + (size_t)nt * 128 * 1024;
    gemm256(accA, accB, 1024,
            [&](int r, int k) { return *(const uint4*)(A + (size_t)r * 1024 + k); },
            [&](int r, int k) { return *(const uint4*)(B + (size_t)r * 1024 + k); }, (bf16_t*)smem);
    __syncthreads();
    float* stg = (float*)smem + wave * (32 * 68);
    p4_epilogue(p, accA, mt * 256 + wm * 128, nt * 128 + wn * 64, lane, stg);
    p4_epilogue(p, accB, mt * 256 + wm * 128 + 64, nt * 128 + wn * 64, lane, stg);
  }
}
__device__ void phase5(const Params& p) {
  int tid = threadIdx.x; asm volatile("" : "+v"(tid)); const int lane = tid & 63, wave = tid >> 6;
  for (int row = blockIdx.x * 4 + wave; row < T_TOK; row += gridDim.x * 4) {
    float4* yr = (float4*)(p.out + (size_t)row * 1024);
    const float4* gr = (const float4*)p.final_g;
    float4 v[4]; float ss = 0.f;
#pragma unroll
    for (int i = 0; i < 4; ++i) { v[i] = yr[i * 64 + lane]; ss += v[i].x * v[i].x + v[i].y * v[i].y + v[i].z * v[i].z + v[i].w * v[i].w; }
    ss = wave_sum(ss);
    const float rstd = rsqrtf(ss * (1.f / 1024.f) + 1e-6f);
#pragma unroll
    for (int i = 0; i < 4; ++i) {
      const float4 gg = gr[i * 64 + lane];
      float4 o; o.x = v[i].x * rstd * gg.x; o.y = v[i].y * rstd * gg.y; o.z = v[i].z * rstd * gg.z; o.w = v[i].w * rstd * gg.w;
      st_nt(yr + i * 64 + lane, o);
    }
  }
}

#define XB_TMO      128
#define XB_XCNT(j)  (256  + 64 * (j))
#define XB_XSUB(j)  (1280 + 64 * (j))
#define XB_XGEN(j)  (2304 + 64 * (j))
#define XB_TOP      3328
#define XB_TOPGEN   3392
#define XCD_BAR_WORDS 3456
#define XB_SPIN_CAP (1u << 18)
#define LAS __attribute__((address_space(3)))
DI unsigned xb_ld(unsigned* p) { return __hip_atomic_load(p, __ATOMIC_RELAXED, __HIP_MEMORY_SCOPE_AGENT); }
DI unsigned xb_add(unsigned* p, unsigned v) { return __hip_atomic_fetch_add(p, v, __ATOMIC_RELAXED, __HIP_MEMORY_SCOPE_AGENT); }
DI unsigned xb_xcc_id() { return (unsigned)__builtin_amdgcn_s_getreg((3 << 11) | 20) & 0xFu; }
#define XB_SPIN(cond, bar) do { unsigned _sp = 0; while (cond) { __builtin_amdgcn_s_sleep(1); \
    if ((++_sp & 255u) == 0u) { if (xb_ld(&(bar)[XB_TMO])) break; if (_sp > XB_SPIN_CAP) { atomicAdd(&(bar)[XB_TMO], 1u); break; } } } } while (0)
struct XcdBarrier { unsigned* bar; unsigned x; unsigned* st; };
DI XcdBarrier xcd_barrier_post(unsigned* bar, unsigned* st) {
  XcdBarrier b; b.bar = bar; b.x = xb_xcc_id(); b.st = st;
  if (threadIdx.x == 0) (void)xb_add(&bar[XB_XCNT(b.x)], 1u);
  return b;
}
DI void xcd_barrier_complete(unsigned* bar, unsigned x, unsigned& nloc, unsigned& nx) {
  const unsigned G = gridDim.x * gridDim.y * gridDim.z;
  unsigned sum, cnt, mine, sp = 0u;
  for (;;) {
    sum = 0u; cnt = 0u; mine = 0u;
#pragma unroll
    for (unsigned j = 0; j < 16; ++j) { const unsigned c = xb_ld(&bar[XB_XCNT(j)]); sum += c; cnt += (c > 0u) ? 1u : 0u; mine = (j == x) ? c : mine; }
    if (sum == G) break;
    __builtin_amdgcn_s_sleep(1);
    if ((++sp & 255u) == 0u) { if (xb_ld(&bar[XB_TMO])) break; if (sp > XB_SPIN_CAP) { atomicAdd(&bar[XB_TMO], 1u); break; } }
  }
  nloc = mine > 0u ? mine : 1u; nx = cnt > 0u ? cnt : 1u;
}
DI void xcd_barrier(const XcdBarrier& b) {
  asm volatile("s_waitcnt vmcnt(0)" ::: "memory");
  __syncthreads();
  if (threadIdx.x == 0) {
    unsigned* bar = b.bar;
    __builtin_amdgcn_s_waitcnt(0);
    unsigned nloc = b.st[0], nx = b.st[1];
    if (nloc == 0u) { xcd_barrier_complete(bar, b.x, nloc, nx); b.st[0] = nloc; b.st[1] = nx; }
    const unsigned old = xb_add(&bar[XB_XSUB(b.x)], 1u);
    const unsigned gen = old / nloc;
    if (old + 1u == (gen + 1u) * nloc) {
      __builtin_amdgcn_fence(__ATOMIC_RELEASE, "agent");
      asm volatile("s_waitcnt vmcnt(0)" ::: "memory");
      const unsigned og = xb_add(&bar[XB_TOP], 1u);
      const unsigned tg = og / nx;
      if (og + 1u == (tg + 1u) * nx) xb_add(&bar[XB_TOPGEN], 1u);
      else XB_SPIN(xb_ld(&bar[XB_TOPGEN]) == tg, bar);
      __builtin_amdgcn_fence(__ATOMIC_ACQUIRE, "agent");
      xb_add(&bar[XB_XGEN(b.x)], 1u);
      asm volatile("s_waitcnt vmcnt(0)" ::: "memory");
    } else {
      XB_SPIN(xb_ld(&bar[XB_XGEN(b.x)]) == gen, bar);
      __builtin_amdgcn_fence(__ATOMIC_ACQUIRE, "agent");
      asm volatile("s_waitcnt vmcnt(0)" ::: "memory");
    }
  }
  __syncthreads();
}

__global__ void __launch_bounds__(256, 2) hymba_megakernel(Params p) {
  __shared__ __attribute__((aligned(16))) char smem[SMEM_BYTES];
  cg::grid_group grid = cg::this_grid();
#ifndef REP
#define REP 0
#endif
  if (p.bar == nullptr) { grid.sync(); return; }
  unsigned* st = p.bar + XCD_BAR_WORDS + 2 * blockIdx.x;
  XcdBarrier xb = xcd_barrier_post(p.bar, st);
#define GRID_SEAM() xcd_barrier(xb)
  prep_items<true>(p, smem); GRID_SEAM();
  phase1a(p, smem); GRID_SEAM();
  phase1b(p, smem); GRID_SEAM();
  phase2(p, smem); GRID_SEAM();
  phase3(p, smem); GRID_SEAM();
  phase4(p, smem); GRID_SEAM();
  phase5(p);
}

extern "C" void kernel_launch(void* const* d_in, const int* in_sizes, int n_in, void* d_out, int out_size, void* d_ws,
                              size_t ws_size, hipStream_t stream) {
  static int grid_blocks = 0;
  static int cus_static = 0;
  if (!cus_static) {
    int dev = 0, cus = 0;
    (void)hipGetDevice(&dev);
    (void)hipDeviceGetAttribute(&cus, hipDeviceAttributeMultiprocessorCount, dev);
    cus_static = cus > 0 ? cus : 256;
  }
  Params p{};
  p.x = (const float*)d_in[0]; p.c = (const float*)d_in[1]; p.pos = (const int*)d_in[2];
  p.ada_w = (const float*)d_in[3]; p.ada_b = (const float*)d_in[4]; p.norm_g = (const float*)d_in[5];
  p.w_in = (const float*)d_in[6]; p.cmp_pos = (const float*)d_in[7]; p.cmp_k_w1 = (const float*)d_in[8];
  p.cmp_k_w2 = (const float*)d_in[9]; p.cmp_v_w1 = (const float*)d_in[10]; p.cmp_v_w2 = (const float*)d_in[11];
  p.q_norm_g = (const float*)d_in[12]; p.w_q_up = (const float*)d_in[13]; p.kv_norm_g = (const float*)d_in[14];
  p.w_kv_up = (const float*)d_in[15]; p.w_out = (const float*)d_in[16]; p.final_g = (const float*)d_in[17];
  p.out = (float*)d_out;
  char* w = (char*)d_ws; size_t off = 0;
  auto take = [&](size_t bytes) { char* r = w + off; off += (bytes + 255) & ~(size_t)255; return r; };
  p.WinT = (bf16_t*)take((size_t)NPADW * 1024 * 2);
  p.WoutT = (bf16_t*)take((size_t)1024 * 1024 * 2);
  p.WqT = (bf16_t*)take((size_t)768 * 256 * 2);
  p.WkvT = (bf16_t*)take((size_t)1024 * 128 * 2);
  p.W1kT = (bf16_t*)take((size_t)128 * 2048 * 2);
  p.W1vT = (bf16_t*)take((size_t)128 * 2048 * 2);
  p.W2kT = (bf16_t*)take((size_t)64 * 128 * 2);
  p.W2vT = (bf16_t*)take((size_t)64 * 128 * 2);
  p.bar = (unsigned*)take((size_t)(XCD_BAR_WORDS + 2 * 4096 + 64 * 10) * 4);
  p.modp = (float*)take((size_t)16 * 4 * 3072 * 4);
  p.gatef = (float*)take((size_t)4096 * 4);
  p.cbp = (float*)take((size_t)2 * 8 * 128 * 4);
  p.cpart = (float*)take((size_t)256 * 16384 * 4);
  p.cs64 = (float2*)take((size_t)T_TOK * 32 * 8);
  p.cs32 = (float2*)take((size_t)T_TOK * 16 * 8);
  p.H = (bf16_t*)take((size_t)T_TOK * 1024 * 2);
  p.MIX = p.H;
  p.P = (bf16_t*)take((size_t)T_TOK * LDP * 2);
  p.VsT = (bf16_t*)take((size_t)4 * 2 * 64 * S_LEN * 2);
  p.VwT = (bf16_t*)take((size_t)4 * 2 * 64 * S_LEN * 2);
  p.ssq = (float*)take((size_t)T_TOK * 8 * 4);
  p.Qm = (bf16_t*)take((size_t)T_TOK * 768 * 2);
  p.Kn = (bf16_t*)take((size_t)T_TOK * 512 * 2);
  p.VmT = (bf16_t*)take((size_t)4 * 8 * 64 * S_LEN * 2);
  p.KC = (bf16_t*)take((size_t)8 * 256 * 64 * 2);
  p.VCt = (bf16_t*)take((size_t)8 * 64 * 256 * 2);
  for (int i = 0; i < 32; ++i) p.inv64[i] = pow(10000.0, -(double)i / 32.0);
  for (int i = 0; i < 16; ++i) p.inv32[i] = pow(10000.0, -(double)i / 16.0);
  {
    double cost[256]; unsigned char code[256];
    for (int r = 0; r < 4; ++r) for (int qt = 0; qt < 32; ++qt) { cost[r * 32 + qt] = 1.0 * (2 * qt + 2) + 1.0; code[r * 32 + qt] = (unsigned char)((r << 5) | qt); }
    for (int t = 0; t < 128; ++t) {
      const double win = (t / 2 + 1) < 9.5 ? (t / 2 + 1) : 9.5;
      cost[128 + t] = 1.25 * ((t / 2 + 1) + win + 2.0 * (t / 32 + 1)) + 6.0; code[128 + t] = (unsigned char)(128 | t);
    }
    for (int i = 0; i < 256; ++i) {
      int best = i;
      for (int j = i + 1; j < 256; ++j) if (cost[j] > cost[best]) best = j;
      const double tc = cost[i]; cost[i] = cost[best]; cost[best] = tc;
      const unsigned char tk = code[i]; code[i] = code[best]; code[best] = tk;
    }
    unsigned char ord[256]; bool used[256]; int n = 0, nm = 0;
    for (int i = 0; i < 256; ++i) used[i] = false;
    for (int i = 0; i < 256 && nm < 64; ++i) if (!(code[i] & 128)) { ord[n++] = code[i]; used[i] = true; ++nm; }
    for (int i = 0; i < 256; ++i) if (!used[i]) ord[n++] = code[i];
    for (int i = 0; i < 256; ++i) p.order[i] = ord[i];
  }
  void* args[] = {&p};
  (void)hipMemsetAsync(p.bar, 0, (size_t)(XCD_BAR_WORDS + 2 * 4096 + 64 * 10) * 4, stream);
  if (!grid_blocks) {
    hipError_t e = hipLaunchCooperativeKernel((void*)hymba_megakernel, dim3(cus_static * 2), dim3(256), args, 0, stream);
    if (e == hipSuccess) { grid_blocks = cus_static * 2; return; }
    (void)hipGetLastError();
    grid_blocks = cus_static;
  }
  hipError_t e = hipLaunchCooperativeKernel((void*)hymba_megakernel, dim3(grid_blocks), dim3(256), args, 0, stream);
  if (e != hipSuccess) fprintf(stderr, "cooperative launch failed: %s (grid %d)\n", hipGetErrorString(e), grid_blocks);
}
```
